# Optimizing an MI355X kernel written in HIP

```python
import jax
import jax.numpy as jnp
from jax import lax
import numpy as np

D_MODEL = 2048
BATCH = 16
SEQ = 256
DEPTH = 2
DEC_BATCH = 2
DEC_SEQ = 1024
PAST_LEN = 256

GRID_W = 64
HEAD_DIM = 128
N_HEADS_A = D_MODEL // (2 * HEAD_DIM)
N_HEADS_B = D_MODEL // (2 * HEAD_DIM)
N_KV_B = max(1, N_HEADS_B // 4)
G_B = N_HEADS_B // N_KV_B
NA_ROWS = 8
NA_COLS = 16
WIN_B = 128
BLK = 128
D_RNN = D_MODEL
N_RG_BLOCKS = 16
RG_BLOCK = D_RNN // N_RG_BLOCKS
CONV_W = 4
CONV_PAD_L = 2
RG_C = 8.0
D_FF = 4 * D_MODEL
ROPE_BASE = 10000.0
EPS = 1e-6
NEG = -1e30
N_ATT_LAYERS = (DEPTH + 1) // 2
N_REC_LAYERS = DEPTH // 2
QA_W = N_HEADS_A * HEAD_DIM
QB_W = N_HEADS_B * HEAD_DIM
KVB_W = N_KV_B * HEAD_DIM
D_ATT_IN = 3 * QA_W + QB_W + 2 * KVB_W
D_ATT_OUT = QA_W + QB_W

kernel_name = "hybrid_diffusion_na_swa_rglru_step"


def rmsnorm(x, g):
    xf = x.astype(jnp.float32)
    y = xf * lax.rsqrt(jnp.mean(xf * xf, axis=-1, keepdims=True) + EPS)
    return (y * g.astype(jnp.float32)).astype(x.dtype)


def adaln(cond, w, b):
    m = jax.nn.silu(cond) @ w + b
    return [t[:, None, :] for t in jnp.split(m, 6, axis=-1)]


def _rope_axis(x, pos):
    d = x.shape[-1]
    inv = ROPE_BASE ** (-jnp.arange(0, d, 2, dtype=jnp.float32) / d)
    ang = pos.astype(jnp.float32)[:, None] * inv[None, :]
    cos = jnp.cos(ang)[None, :, None, :]
    sin = jnp.sin(ang)[None, :, None, :]
    x1, x2 = jnp.split(x.astype(jnp.float32), 2, axis=-1)
    return jnp.concatenate([x1 * cos - x2 * sin, x2 * cos + x1 * sin], axis=-1).astype(x.dtype)


def rope_2d(x):
    t = jnp.arange(x.shape[1])
    half = x.shape[-1] // 2
    return jnp.concatenate([_rope_axis(x[..., :half], t // GRID_W),
                            _rope_axis(x[..., half:], t % GRID_W)], axis=-1)


def dense_ctx_attention(q, k, v, sink):
    s = jnp.einsum('bqhgd,bkhd->bhgqk', q, k).astype(jnp.float32) * (HEAD_DIM ** -0.5)
    if sink is not None:
        B, H, G, Lq, _ = s.shape
        s_sink = jnp.broadcast_to(sink.astype(jnp.float32)[None, :, :, None, None], (B, H, G, Lq, 1))
        p = jax.nn.softmax(jnp.concatenate([s_sink, s], axis=-1), axis=-1)[..., 1:]
    else:
        p = jax.nn.softmax(s, axis=-1)
    return jnp.einsum('bhgqk,bkhd->bqhgd', p.astype(v.dtype), v)


def neighbourhood_attention(q, k, v, kc, vc, rpb):
    B, T, H, D = q.shape
    R = T // GRID_W
    kh = min(NA_ROWS, R)
    r = jnp.arange(R)
    row_idx = jnp.clip(r - kh // 2, 0, R - kh)[:, None] + jnp.arange(kh)[None, :]
    j = jnp.arange(GRID_W)
    start_c = jnp.clip(j - NA_COLS // 2, 0, GRID_W - NA_COLS)
    qg = q.reshape(B, R, GRID_W, H, D)
    kb = k.reshape(B, R, GRID_W, H, D)[:, row_idx]
    vb = v.reshape(B, R, GRID_W, H, D)[:, row_idx]
    s = jnp.einsum('brqhd,brikhd->bhrqik', qg, kb).astype(jnp.float32) * (HEAD_DIM ** -0.5)
    dr = row_idx - r[:, None] + (NA_ROWS - 1)
    dc = jnp.clip(j[None, :] - j[:, None] + (NA_COLS - 1), 0, 2 * NA_COLS - 2)
    in_win = (j[None, :] >= start_c[:, None]) & (j[None, :] < start_c[:, None] + NA_COLS)
    bias = rpb[:, dr[:, None, :, None], dc[None, :, None, :]].astype(jnp.float32)
    s = jnp.where(in_win[None, None, None, :, None, :], s + bias[None], NEG)
    sc = jnp.einsum('brqhd,bchd->bhrqc', qg, kc).astype(jnp.float32) * (HEAD_DIM ** -0.5)
    nk = kh * GRID_W
    p = jax.nn.softmax(jnp.concatenate([s.reshape(B, H, R, GRID_W, nk), sc], axis=-1), axis=-1)
    p_nb = p[..., :nk].reshape(B, H, R, GRID_W, kh, GRID_W).astype(v.dtype)
    p_c = p[..., nk:].astype(v.dtype)
    o = jnp.einsum('bhrqik,brikhd->brqhd', p_nb, vb) + jnp.einsum('bhrqc,bchd->brqhd', p_c, vc)
    return o.reshape(B, T, H, D)


def window_attention(q, k, v, kc, vc, sink):
    B, T, Hkv, G, D = q.shape
    nb = T // BLK
    qb = q.reshape(B, nb, BLK, Hkv, G, D)
    pad = jnp.zeros((B, BLK, Hkv, D), k.dtype)
    kp = jnp.concatenate([pad, k, pad], axis=1)
    vp = jnp.concatenate([pad, v, pad], axis=1)
    idx = jnp.arange(nb)[:, None] * BLK + jnp.arange(3 * BLK)[None, :]
    kb = kp[:, idx]
    vb = vp[:, idx]
    qpos = jnp.arange(nb)[:, None] * BLK + jnp.arange(BLK)[None, :]
    kpos = idx - BLK
    valid = ((jnp.abs(qpos[:, :, None] - kpos[:, None, :]) <= WIN_B)
             & (kpos >= 0)[:, None, :] & (kpos < T)[:, None, :])
    s = jnp.einsum('bnqhgd,bnkhd->bhgnqk', qb, kb).astype(jnp.float32) * (HEAD_DIM ** -0.5)
    s = jnp.where(valid[None, None, None], s, NEG)
    sc = jnp.einsum('bnqhgd,bchd->bhgnqc', qb, kc).astype(jnp.float32) * (HEAD_DIM ** -0.5)
    s_sink = jnp.broadcast_to(sink.astype(jnp.float32)[None, :, :, None, None, None], (B, Hkv, G, nb, BLK, 1))
    p = jax.nn.softmax(jnp.concatenate([s_sink, s, sc], axis=-1), axis=-1)
    p_band = p[..., 1:1 + 3 * BLK].astype(v.dtype)
    p_ctx = p[..., 1 + 3 * BLK:].astype(v.dtype)
    o = jnp.einsum('bhgnqk,bnkhd->bnqhgd', p_band, vb) + jnp.einsum('bhgnqc,bchd->bnqhgd', p_ctx, vc)
    return o.reshape(B, T, Hkv * G, D)


def att_project(h, w_in):
    B, L, _ = h.shape
    cuts = [QA_W, 2 * QA_W, 3 * QA_W, 3 * QA_W + QB_W, 3 * QA_W + QB_W + KVB_W]
    qa, ka, va, qb, kb, vb = jnp.split(h @ w_in, cuts, axis=-1)
    sa = (B, L, N_HEADS_A, HEAD_DIM)
    skv = (B, L, N_KV_B, HEAD_DIM)
    return (qa.reshape(sa), ka.reshape(sa), va.reshape(sa),
            qb.reshape(B, L, N_HEADS_B, HEAD_DIM), kb.reshape(skv), vb.reshape(skv))


def att_mixer_ctx(h, w_in, w_out, sink):
    B, L, _ = h.shape
    qa, ka, va, qb, kb, vb = att_project(h, w_in)
    oa = dense_ctx_attention(qa[:, :, :, None, :], ka, va, None)
    ob = dense_ctx_attention(qb.reshape(B, L, N_KV_B, G_B, HEAD_DIM), kb, vb, sink)
    o = jnp.concatenate([oa.reshape(B, L, QA_W), ob.reshape(B, L, QB_W)], axis=-1) @ w_out
    return o, ka, va, kb, vb


def att_mixer_lat(h, w_in, w_out, sink, rpb, ak, av, bk, bv):
    B, T, _ = h.shape
    qa, ka, va, qb, kb, vb = att_project(h, w_in)
    qb = rope_2d(qb)
    kb = rope_2d(kb)
    oa = neighbourhood_attention(qa, ka, va, ak, av, rpb)
    ob = window_attention(qb.reshape(B, T, N_KV_B, G_B, HEAD_DIM), kb, vb, bk, bv, sink)
    return jnp.concatenate([oa.reshape(B, T, QA_W), ob.reshape(B, T, QB_W)], axis=-1) @ w_out


def depthwise_conv(x, w, b):
    y = lax.conv_general_dilated(x, w[:, None, :].astype(x.dtype), window_strides=(1,),
                                 padding=[(CONV_PAD_L, CONV_W - 1 - CONV_PAD_L)],
                                 dimension_numbers=('NWC', 'WIO', 'NWC'),
                                 feature_group_count=x.shape[-1])
    return y + b


def _lin_combine(left, right):
    a_l, b_l = left
    a_r, b_r = right
    return a_l * a_r, a_r * b_l + b_r


def rglru(x, w_a, b_a, w_x, b_x, lam, h0, reverse):
    B, T, _ = x.shape
    xb = x.reshape(B, T, N_RG_BLOCKS, RG_BLOCK)
    gate_a = jnp.einsum('btnk,nkj->btnj', xb, w_a).reshape(B, T, D_RNN) + b_a
    gate_x = jnp.einsum('btnk,nkj->btnj', xb, w_x).reshape(B, T, D_RNN) + b_x
    r = jax.nn.sigmoid(gate_a.astype(jnp.float32))
    i = jax.nn.sigmoid(gate_x.astype(jnp.float32))
    log_a = -RG_C * r * jax.nn.softplus(-lam.astype(jnp.float32))
    a = jnp.exp(log_a)
    bcoef = jnp.sqrt(-jnp.expm1(2.0 * log_a)) * i * x.astype(jnp.float32)
    h0 = h0.astype(jnp.float32)
    if reverse:
        bcoef = bcoef.at[:, -1].add(a[:, -1] * h0)
    else:
        bcoef = bcoef.at[:, 0].add(a[:, 0] * h0)
    _, h = lax.associative_scan(_lin_combine, (a, bcoef), reverse=reverse, axis=1)
    return h


def rec_mixer(h, w_in, cw, cb, w_a, b_a, w_x, b_x, lam, w_out, h0f, h0b):
    xr, g = jnp.split(h @ w_in, 2, axis=-1)
    xr = depthwise_conv(xr, cw, cb)
    hf = rglru(xr, w_a[0], b_a[0], w_x[0], b_x[0], lam[0], h0f, False)
    hb = rglru(xr, w_a[1], b_a[1], w_x[1], b_x[1], lam[1], h0b, True)
    y = ((hf + hb) * jax.nn.gelu(g.astype(jnp.float32))).astype(h.dtype)
    return y @ w_out, hf, hb


def ffn(h, w1, w2):
    a = jnp.maximum(h @ w1, 0)
    return (a * a) @ w2


def setup_inputs(seed: int = 0) -> dict:
    key = jax.random.key(seed)
    ks = iter(jax.random.split(key, 40))

    def nrm(shape, scale):
        return jax.random.normal(next(ks), shape, jnp.float32) * scale

    u = jax.random.uniform(next(ks), (N_REC_LAYERS, 2, D_RNN), jnp.float32, minval=0.9, maxval=0.999)
    a0 = u ** (1.0 / RG_C)
    rg_lambda = jnp.log(a0) - jnp.log1p(-a0)
    return {
        'x_prompt': nrm((BATCH, SEQ, D_MODEL), 1.0),
        'x_sample': nrm((DEC_BATCH, DEC_SEQ, D_MODEL), 1.0),
        'c': nrm((DEC_BATCH, D_MODEL), 1.0),
        'cache_a_k': nrm((DEC_BATCH, N_ATT_LAYERS, PAST_LEN, N_HEADS_A, HEAD_DIM), 1.0),
        'cache_a_v': nrm((DEC_BATCH, N_ATT_LAYERS, PAST_LEN, N_HEADS_A, HEAD_DIM), 1.0),
        'cache_b_k': nrm((DEC_BATCH, N_ATT_LAYERS, PAST_LEN, N_KV_B, HEAD_DIM), 1.0),
        'cache_b_v': nrm((DEC_BATCH, N_ATT_LAYERS, PAST_LEN, N_KV_B, HEAD_DIM), 1.0),
        'state_rg_fwd': nrm((DEC_BATCH, N_REC_LAYERS, D_RNN), 0.5),
        'state_rg_bwd': nrm((DEC_BATCH, N_REC_LAYERS, D_RNN), 0.5),
        'c_ctx': nrm((D_MODEL,), 1.0),
        'w_ada': nrm((DEPTH, D_MODEL, 6 * D_MODEL), 0.5 * D_MODEL ** -0.5),
        'b_ada': nrm((DEPTH, 6 * D_MODEL), 0.02),
        'g_pre_mix': 1.0 + nrm((DEPTH, D_MODEL), 0.05),
        'g_post_mix': 1.0 + nrm((DEPTH, D_MODEL), 0.05),
        'g_pre_ffn': 1.0 + nrm((DEPTH, D_MODEL), 0.05),
        'g_post_ffn': 1.0 + nrm((DEPTH, D_MODEL), 0.05),
        'w_att_in': nrm((N_ATT_LAYERS, D_MODEL, D_ATT_IN), D_MODEL ** -0.5),
        'w_att_out': nrm((N_ATT_LAYERS, D_ATT_OUT, D_MODEL), D_ATT_OUT ** -0.5),
        'sink_b': nrm((N_ATT_LAYERS, N_KV_B, G_B), 0.5),
        'rpb_a': nrm((N_ATT_LAYERS, N_HEADS_A, 2 * NA_ROWS - 1, 2 * NA_COLS - 1), 0.1),
        'w_rec_in': nrm((N_REC_LAYERS, D_MODEL, 2 * D_RNN), D_MODEL ** -0.5),
        'conv_w': nrm((N_REC_LAYERS, CONV_W, D_RNN), CONV_W ** -0.5),
        'conv_b': nrm((N_REC_LAYERS, D_RNN), 0.02),
        'w_rg_a': nrm((N_REC_LAYERS, 2, N_RG_BLOCKS, RG_BLOCK, RG_BLOCK), RG_BLOCK ** -0.5),
        'b_rg_a': nrm((N_REC_LAYERS, 2, D_RNN), 0.02),
        'w_rg_x': nrm((N_REC_LAYERS, 2, N_RG_BLOCKS, RG_BLOCK, RG_BLOCK), RG_BLOCK ** -0.5),
        'b_rg_x': nrm((N_REC_LAYERS, 2, D_RNN), 0.02),
        'rg_lambda': rg_lambda,
        'w_rec_out': nrm((N_REC_LAYERS, D_RNN, D_MODEL), D_RNN ** -0.5),
        'w_ff1': nrm((DEPTH, D_MODEL, D_FF), D_MODEL ** -0.5),
        'w_ff2': nrm((DEPTH, D_FF, D_MODEL), D_FF ** -0.5),
    }


def reference(x_prompt, x_sample, c, cache_a_k, cache_a_v, cache_b_k, cache_b_v, state_rg_fwd,
              state_rg_bwd, c_ctx, w_ada, b_ada, g_pre_mix, g_post_mix, g_pre_ffn, g_post_ffn,
              w_att_in, w_att_out, sink_b, rpb_a, w_rec_in, conv_w, conv_b, w_rg_a, b_rg_a,
              w_rg_x, b_rg_x, rg_lambda, w_rec_out, w_ff1, w_ff2):
    yp, ys = x_prompt, x_sample
    ctx_cond = c_ctx[None, :]
    ak_l, av_l, bk_l, bv_l, sf_l, sb_l = [], [], [], [], [], []
    for layer in range(DEPTH):
        shm_p, scm_p, gm_p, shf_p, scf_p, gf_p = adaln(ctx_cond, w_ada[layer], b_ada[layer])
        shm_s, scm_s, gm_s, shf_s, scf_s, gf_s = adaln(c, w_ada[layer], b_ada[layer])
        hp = rmsnorm(yp, g_pre_mix[layer]) * (1 + scm_p) + shm_p
        hs = rmsnorm(ys, g_pre_mix[layer]) * (1 + scm_s) + shm_s
        li = layer // 2
        if layer % 2 == 0:
            op, ka, va, kb, vb = att_mixer_ctx(hp, w_att_in[li], w_att_out[li], sink_b[li])
            os_ = att_mixer_lat(hs, w_att_in[li], w_att_out[li], sink_b[li], rpb_a[li],
                                cache_a_k[:, li], cache_a_v[:, li], cache_b_k[:, li], cache_b_v[:, li])
            ak_l.append(ka)
            av_l.append(va)
            bk_l.append(kb)
            bv_l.append(vb)
        else:
            zeros = jnp.zeros((yp.shape[0], D_RNN), yp.dtype)
            op, hf, hb = rec_mixer(hp, w_rec_in[li], conv_w[li], conv_b[li], w_rg_a[li], b_rg_a[li],
                                   w_rg_x[li], b_rg_x[li], rg_lambda[li], w_rec_out[li], zeros, zeros)
            os_, _, _ = rec_mixer(hs, w_rec_in[li], conv_w[li], conv_b[li], w_rg_a[li], b_rg_a[li],
                                  w_rg_x[li], b_rg_x[li], rg_lambda[li], w_rec_out[li],
                                  state_rg_fwd[:, li], state_rg_bwd[:, li])
            sf_l.append(hf[:, -1].astype(yp.dtype))
            sb_l.append(hb[:, 0].astype(yp.dtype))
        yp = yp + gm_p * rmsnorm(op, g_post_mix[layer])
        ys = ys + gm_s * rmsnorm(os_, g_post_mix[layer])
        hp = rmsnorm(yp, g_pre_ffn[layer]) * (1 + scf_p) + shf_p
        hs = rmsnorm(ys, g_pre_ffn[layer]) * (1 + scf_s) + shf_s
        yp = yp + gf_p * rmsnorm(ffn(hp, w_ff1[layer], w_ff2[layer]), g_post_ffn[layer])
        ys = ys + gf_s * rmsnorm(ffn(hs, w_ff1[layer], w_ff2[layer]), g_post_ffn[layer])
    return (yp, ys, jnp.stack(ak_l, axis=1), jnp.stack(av_l, axis=1), jnp.stack(bk_l, axis=1),
            jnp.stack(bv_l, axis=1), jnp.stack(sf_l, axis=1), jnp.stack(sb_l, axis=1))
```

```cpp
#include <hip/hip_runtime.h>
#include <hip/hip_cooperative_groups.h>
#include <cstdio>
#include <cstdint>
namespace cg = cooperative_groups;

constexpr int OUT_YP = 0, OUT_YS = 8388608, OUT_AK = 12582912, OUT_AV = 16777216, OUT_BK = 20971520, OUT_BV = 22020096, OUT_RF = 23068672, OUT_RB = 23101440;
typedef float f32x2_t __attribute__((ext_vector_type(2)));
typedef __bf16 bf16x2_t __attribute__((ext_vector_type(2)));
__device__ __forceinline__ unsigned pk2(float lo, float hi) { f32x2_t v = {lo, hi}; bf16x2_t b = __builtin_convertvector(v, bf16x2_t); return __builtin_bit_cast(unsigned, b); }
__device__ __forceinline__ float bf2f(unsigned short h) { return __builtin_bit_cast(float, (unsigned)h << 16); }
namespace pg8 {
#define PG8_LAS __attribute__((address_space(3)))
typedef unsigned short bf16_t;
typedef short bf16x8 __attribute__((ext_vector_type(8)));
typedef float f32x4 __attribute__((ext_vector_type(4)));
typedef unsigned u32x4 __attribute__((ext_vector_type(4)));
constexpr int BM = 256, BK = 64, HALF = 128, HTB = HALF * BK * 2  , STAGE_BYTES = 8 * HTB, NXCD = 8, WGM = 8;

__host__ __device__ __forceinline__ int lds_byte(int r, int c) { const int st = (r >> 4) * 2 + (c >> 5), rr = r & 15, cc = c & 31, ob = rr * 64 + cc * 2; return st * 1024 + (ob ^ (((ob >> 9) & 1) << 5)); }
__host__ __device__ __forceinline__ void stage_rc(int b, int& R, int& C) { const int st = b / 1024, sb = b % 1024, swz = sb ^ (((sb >> 9) & 1) << 5); R = (st >> 1) * 16 + swz / 64; C = (st & 1) * 32 + (swz % 64) / 2; }
__host__ __device__ __forceinline__ int perm32(int rho) { const int n = rho >> 4, i = rho & 15; return 8 * (i >> 2) + 4 * n + (i & 3); }

struct Unit { int pm, pn; };
struct Gemm { const bf16_t* A; const bf16_t* Bt; int M, N, K; };

struct StaticOrder {
    int nM, nN, nwg, G, c;
    __host__ __device__ void init(int M, int N, int G_, int c_) { nM = M / BM; nN = N / BM; nwg = nM * nN; G = G_; c = c_; }
    __host__ __device__ bool next(int i, Unit& u) const {
        const long L = (long)i * G + c; if (L >= nwg) return false;
        int wgid = (int)L; { const int q = nwg / NXCD, r = nwg % NXCD, xcd = wgid % NXCD, off = wgid / NXCD; wgid = (xcd < r ? xcd * (q + 1) : r * (q + 1) + (xcd - r) * q) + off; }
        const int nig = WGM * nN, gid = wgid / nig, fm = gid * WGM, gsz = (nM - fm) < WGM ? (nM - fm) : WGM;
        u.pm = fm + ((wgid % nig) % gsz); u.pn = (wgid % nig) / gsz; return true;
    }
    __device__ __forceinline__ void a_ready(const Unit&) const {}
    __device__ __forceinline__ void done(const Unit&) const {}
};

struct EpiF32 {
    static constexpr bool PERM = false, AFTER_DRAIN = false;
    float* O; int ldc;
    __device__ __forceinline__ void operator()(const f32x4 (&acc)[2][2][4][2], const Unit& u, int wr, int wc, int fr, int fq) const {
        const int row0 = u.pm * BM + wr * 64 + fr, col0 = u.pn * BM + wc * 32 + 4 * fq;
#pragma unroll
        for (int ai = 0; ai < 2; ++ai)
#pragma unroll
            for (int m = 0; m < 4; ++m) { float* rowp = O + (size_t)(row0 + ai * HALF + m * 16) * ldc + col0;
#pragma unroll
                for (int bj = 0; bj < 2; ++bj)
#pragma unroll
                    for (int n = 0; n < 2; ++n) *(f32x4*)(rowp + bj * HALF + n * 16) = acc[ai][bj][m][n]; }
    }
};
template <int ACT  > struct EpiBf16 {
    static constexpr bool PERM = true, AFTER_DRAIN = false;
    bf16_t* O; int ldc;
    __device__ __forceinline__ void operator()(const f32x4 (&acc)[2][2][4][2], const Unit& u, int wr, int wc, int fr, int fq) const {
        const int row0 = u.pm * BM + wr * 64 + fr, col0 = u.pn * BM + wc * 32 + 8 * fq;
#pragma unroll
        for (int ai = 0; ai < 2; ++ai)
#pragma unroll
            for (int m = 0; m < 4; ++m) { bf16_t* rowp = O + (size_t)(row0 + ai * HALF + m * 16) * ldc + col0;
#pragma unroll
                for (int bj = 0; bj < 2; ++bj) { f32x4 v0 = acc[ai][bj][m][0], v1 = acc[ai][bj][m][1];
                    if (ACT == 2) {
#pragma unroll
                        for (int i = 0; i < 4; ++i) { const float a = fmaxf(v0[i], 0.f), b = fmaxf(v1[i], 0.f); v0[i] = a * a; v1[i] = b * b; } }
                    u32x4 w; w.x = pk2(v0[0], v0[1]); w.y = pk2(v0[2], v0[3]); w.z = pk2(v1[0], v1[1]); w.w = pk2(v1[2], v1[3]);
                    *(u32x4*)(rowp + bj * HALF) = w; } }
    }
};
struct EpiQKV {
    static constexpr bool PERM = true, AFTER_DRAIN = false;
    bf16_t* QKV; bf16_t* VT; float* out; const float* rope;
    __device__ __forceinline__ void operator()(const f32x4 (&acc)[2][2][4][2], const Unit& u, int wr, int wc, int fr, int fq) const {
        const int pn = u.pn, pm = u.pm; const bool prompt = pm < 16;
        const int row0 = pm * BM + wr * 64 + fr, colp = wc * 32 + 8 * fq;
        if ((pn >= 8 && pn < 12) || pn == 17) {
            const bool isb = (pn == 17);
            const int vcol0 = isb ? 1024 : (pn - 8) * 256;
            float* of = out + (isb ? OUT_BV : OUT_AV); const int ldo = isb ? 256 : 1024, ocol0 = isb ? 0 : (pn - 8) * 256;
#pragma unroll
            for (int ai = 0; ai < 2; ++ai)
#pragma unroll
                for (int m = 0; m < 4; ++m) { const int row = row0 + ai * HALF + m * 16;
#pragma unroll
                    for (int bj = 0; bj < 2; ++bj) { const f32x4 v0 = acc[ai][bj][m][0], v1 = acc[ai][bj][m][1]; const int c = bj * HALF + colp;
                        bf16_t* vp = VT + (size_t)(vcol0 + c) * 6144 + row;
                        const unsigned w0 = pk2(v0[0], v0[1]), w1 = pk2(v0[2], v0[3]), w2 = pk2(v1[0], v1[1]), w3 = pk2(v1[2], v1[3]);
                        vp[0 * 6144] = (bf16_t)(w0 & 0xffffu); vp[1 * 6144] = (bf16_t)(w0 >> 16); vp[2 * 6144] = (bf16_t)(w1 & 0xffffu); vp[3 * 6144] = (bf16_t)(w1 >> 16);
                        vp[4 * 6144] = (bf16_t)(w2 & 0xffffu); vp[5 * 6144] = (bf16_t)(w2 >> 16); vp[6 * 6144] = (bf16_t)(w3 & 0xffffu); vp[7 * 6144] = (bf16_t)(w3 >> 16);
                        if (prompt) { float* op = of + (size_t)row * ldo + ocol0 + c; *(f32x4*)op = v0; *(f32x4*)(op + 4) = v1; } } }
        } else {
            const bool ropeT = (pn >= 12) && !prompt;
            const bool isKA = (pn >= 4 && pn < 8) && prompt, isKB = (pn == 16) && prompt;
            const int e0 = 16 * (wc & 1) + 4 * fq, dlog = 64 * (wc >> 1) + e0;
#pragma unroll
            for (int ai = 0; ai < 2; ++ai)
#pragma unroll
                for (int m = 0; m < 4; ++m) { const int row = row0 + ai * HALF + m * 16;
                    f32x4 cs = {1.f, 1.f, 1.f, 1.f}, sn = {0.f, 0.f, 0.f, 0.f};
                    if (ropeT) { const int t = (row - 4096) & 1023; const int pos = (wc >> 1) ? (t & 63) : (t >> 6);
                        const f32x4 a = *(const f32x4*)(rope + (size_t)(pos * 32 + e0) * 2), b = *(const f32x4*)(rope + (size_t)(pos * 32 + e0) * 2 + 4);
                        cs = (f32x4){a[0], a[2], b[0], b[2]}; sn = (f32x4){a[1], a[3], b[1], b[3]}; }
#pragma unroll
                    for (int bj = 0; bj < 2; ++bj) { f32x4 v0 = acc[ai][bj][m][0], v1 = acc[ai][bj][m][1];
                        if (ropeT) { const f32x4 o0 = v0 * cs - v1 * sn, o1 = v1 * cs + v0 * sn; v0 = o0; v1 = o1; }
                        u32x4 w; w.x = pk2(v0[0], v0[1]); w.y = pk2(v0[2], v0[3]); w.z = pk2(v1[0], v1[1]); w.w = pk2(v1[2], v1[3]);
                        *(u32x4*)(QKV + (size_t)row * 4608 + pn * BM + bj * HALF + colp) = w;
                        if (isKA) { float* op = out + OUT_AK + (size_t)row * 1024 + (pn - 4) * 256 + bj * HALF + colp; *(f32x4*)op = v0; *(f32x4*)(op + 4) = v1; }
                        if (isKB) { float* op = out + OUT_BK + (size_t)row * 256 + bj * HALF + dlog; *(f32x4*)op = v0; *(f32x4*)(op + 32) = v1; } } }
        }
    }
};
template <class Epi, class Sched, bool ALIGN_EPI = false, bool SP2 = false>
__device__ __forceinline__ void gemm_phase(PG8_LAS unsigned char* lds, const Gemm g, const Sched& S, const Epi& E) {
    const int tid = threadIdx.x, wid = __builtin_amdgcn_readfirstlane(tid >> 6), lane = tid & 63, wr = wid >> 2, wc = wid & 3, fr = lane & 15, fq = lane >> 4;
    const int K = g.K, nt = K / BK;
    unsigned voffA[2], voffB[2];
#pragma unroll
    for (int i = 0; i < 2; ++i) { int R, C; stage_rc(tid * 16 + i * 8192, R, C); const int Rb = Epi::PERM ? ((R & ~31) + perm32(R & 31)) : R;
        voffA[i] = (unsigned)(R * K + C) * 2u; voffB[i] = (unsigned)(Rb * K + C) * 2u; }
    const size_t kstep = (size_t)(BK * 2);
    const size_t hstep = (size_t)HALF * K * 2;
    const size_t tstep = 2 * hstep;
    const unsigned ldsw = (unsigned)wid * 1024u;
    const int aoff = lds_byte(wr * 64 + fr, fq * 8), boff = lds_byte(wc * 32 + fr, fq * 8);
#define PG8_SA(b, h) (((b) * 2 + (h)) * HTB)
#define PG8_SB(b, h) ((4 + (b) * 2 + (h)) * HTB)
#define PG8_STAGE(bufoff, gbase, voff) do { _Pragma("unroll") for (int _i = 0; _i < 2; ++_i) \
        __builtin_amdgcn_global_load_lds((const unsigned*)((const char*)(gbase) + (voff)[_i]), (PG8_LAS unsigned*)(lds + (bufoff) + ldsw + _i * 8192), 16, 0, 0); } while (0)
#define PG8_LDA(dst, b, h) do { _Pragma("unroll") for (int m = 0; m < 4; ++m) _Pragma("unroll") for (int k = 0; k < 2; ++k) dst[m][k] = *(const PG8_LAS bf16x8*)(lds + PG8_SA(b, h) + aoff + m * 2048 + k * 1024); } while (0)
#define PG8_LDB(dst, b, h) do { _Pragma("unroll") for (int n = 0; n < 2; ++n) _Pragma("unroll") for (int k = 0; k < 2; ++k) dst[n][k] = *(const PG8_LAS bf16x8*)(lds + PG8_SB(b, h) + boff + n * 2048 + k * 1024); } while (0)
#define PG8_MMA(ai, bj, At, Bt) do { __builtin_amdgcn_s_setprio(1); _Pragma("unroll") for (int m = 0; m < 4; ++m) _Pragma("unroll") for (int n = 0; n < 2; ++n) _Pragma("unroll") for (int k = 0; k < 2; ++k) \
        acc[ai][bj][m][n] = __builtin_amdgcn_mfma_f32_16x16x32_bf16(Bt[n][k], At[m][k], acc[ai][bj][m][n], 0, 0, 0); __builtin_amdgcn_s_setprio(0); } while (0)
#define PG8_WAIT_V(n) asm volatile("s_waitcnt vmcnt(" #n ")" ::: "memory")
#define PG8_WAIT_L(n) asm volatile("s_waitcnt lgkmcnt(" #n ")" ::: "memory")
#define PG8_BAR __builtin_amdgcn_s_barrier()
#define PG8_SCHED __builtin_amdgcn_sched_barrier(0)
    Unit cur, nxt; int ui = 0;
    if (!S.next(0, cur)) return;
    f32x4 acc[2][2][4][2];
#pragma unroll
    for (int a = 0; a < 2; ++a)
#pragma unroll
        for (int b = 0; b < 2; ++b)
#pragma unroll
            for (int m = 0; m < 4; ++m)
#pragma unroll
                for (int n = 0; n < 2; ++n) acc[a][b][m][n] = (f32x4){0.f, 0.f, 0.f, 0.f};
    bf16x8 At[4][2], B0[2][2], B1[2][2];
    const char* cA = (const char*)g.A + (size_t)cur.pm * tstep; const char* cB = (const char*)g.Bt + (size_t)cur.pn * tstep;
    S.a_ready(cur);
    if constexpr (SP2) {
        PG8_STAGE(PG8_SB(0, 0), cB, voffB); PG8_STAGE(PG8_SB(0, 1), cB + hstep, voffB); PG8_STAGE(PG8_SA(0, 0), cA, voffA); PG8_STAGE(PG8_SA(0, 1), cA + hstep, voffA);
        if (wr == 1) PG8_BAR;
        PG8_WAIT_V(2); PG8_BAR;
        PG8_STAGE(PG8_SB(1, 0), cB + kstep, voffB); PG8_STAGE(PG8_SA(1, 0), cA + kstep, voffA); PG8_STAGE(PG8_SB(1, 1), cB + hstep + kstep, voffB);
        PG8_WAIT_V(6); PG8_BAR;
    } else {
        PG8_STAGE(PG8_SB(0, 0), cB, voffB); PG8_STAGE(PG8_SA(0, 0), cA, voffA); PG8_STAGE(PG8_SB(0, 1), cB + hstep, voffB); PG8_STAGE(PG8_SA(0, 1), cA + hstep, voffA);
        if (wr == 1) PG8_BAR;
        PG8_WAIT_V(4); PG8_BAR;
        PG8_STAGE(PG8_SB(1, 0), cB + kstep, voffB); PG8_STAGE(PG8_SA(1, 0), cA + kstep, voffA); PG8_STAGE(PG8_SB(1, 1), cB + hstep + kstep, voffB);
        PG8_WAIT_V(6); PG8_BAR;
    }
    for (;;) {
        const bool has_next = S.next(ui + 1, nxt);
        const char* nA = has_next ? (const char*)g.A + (size_t)nxt.pm * tstep : cA; const char* nB = has_next ? (const char*)g.Bt + (size_t)nxt.pn * tstep : cB;
        for (int t = 0; t < nt; t += 2) {
            const bool last = (t == nt - 2);
            const char* a1 = cA + (size_t)(t + 1) * kstep;
            const char* a2 = last ? nA : cA + (size_t)(t + 2) * kstep; const char* b2 = last ? nB : cB + (size_t)(t + 2) * kstep;
            const char* a3 = a2 + kstep; const char* b3 = b2 + kstep;
            if (last && has_next) S.a_ready(nxt);
            if constexpr (SP2) {
            PG8_LDB(B0, 0, 0); PG8_LDB(B1, 0, 1); PG8_SCHED; PG8_LDA(At, 0, 0); PG8_STAGE(PG8_SA(1, 1), a1 + hstep, voffA);
            PG8_WAIT_V(8); PG8_WAIT_L(0); PG8_BAR; PG8_MMA(0, 0, At, B0); PG8_MMA(0, 1, At, B1); PG8_BAR; PG8_SCHED;
            PG8_LDA(At, 0, 1); PG8_STAGE(PG8_SB(0, 0), b2, voffB); PG8_STAGE(PG8_SB(0, 1), b2 + hstep, voffB); PG8_STAGE(PG8_SA(0, 0), a2, voffA);
            PG8_WAIT_V(8); PG8_WAIT_L(0); PG8_BAR; PG8_MMA(1, 0, At, B0); PG8_MMA(1, 1, At, B1); PG8_BAR; PG8_SCHED;
            PG8_LDB(B0, 1, 0); PG8_LDB(B1, 1, 1); PG8_SCHED; PG8_LDA(At, 1, 0); PG8_STAGE(PG8_SA(0, 1), a2 + hstep, voffA);
            PG8_WAIT_V(8); PG8_WAIT_L(0); PG8_BAR; PG8_MMA(0, 0, At, B0); PG8_MMA(0, 1, At, B1); PG8_BAR; PG8_SCHED;
            PG8_LDA(At, 1, 1); PG8_STAGE(PG8_SB(1, 0), b3, voffB); PG8_STAGE(PG8_SB(1, 1), b3 + hstep, voffB); PG8_STAGE(PG8_SA(1, 0), a3, voffA);
            PG8_WAIT_V(8); PG8_WAIT_L(0); PG8_BAR; PG8_MMA(1, 0, At, B0); PG8_MMA(1, 1, At, B1); PG8_BAR; PG8_SCHED;
            } else {
            PG8_LDB(B0, 0, 0); PG8_SCHED; PG8_LDA(At, 0, 0); PG8_STAGE(PG8_SA(1, 1), a1 + hstep, voffA);
            PG8_WAIT_L(8); PG8_BAR; PG8_WAIT_L(0); PG8_MMA(0, 0, At, B0); PG8_BAR; PG8_SCHED;
            PG8_LDB(B1, 0, 1); PG8_STAGE(PG8_SB(0, 0), b2, voffB);
            PG8_BAR; PG8_WAIT_L(0); PG8_MMA(0, 1, At, B1); PG8_BAR;
            PG8_LDA(At, 0, 1); PG8_STAGE(PG8_SA(0, 0), a2, voffA);
            PG8_BAR; PG8_WAIT_L(0); PG8_MMA(1, 0, At, B0); PG8_BAR; PG8_SCHED;
            PG8_STAGE(PG8_SB(0, 1), b2 + hstep, voffB);
            PG8_WAIT_V(6); PG8_BAR; PG8_MMA(1, 1, At, B1); PG8_BAR;
            PG8_LDB(B0, 1, 0); PG8_SCHED; PG8_LDA(At, 1, 0); PG8_STAGE(PG8_SA(0, 1), a2 + hstep, voffA);
            PG8_WAIT_L(8); PG8_BAR; PG8_WAIT_L(0); PG8_MMA(0, 0, At, B0); PG8_BAR; PG8_SCHED;
            PG8_LDB(B1, 1, 1); PG8_STAGE(PG8_SB(1, 0), b3, voffB);
            PG8_BAR; PG8_WAIT_L(0); PG8_MMA(0, 1, At, B1); PG8_BAR;
            PG8_LDA(At, 1, 1); PG8_STAGE(PG8_SA(1, 0), a3, voffA);
            PG8_BAR; PG8_WAIT_L(0); PG8_MMA(1, 0, At, B0); PG8_BAR; PG8_SCHED;
            PG8_STAGE(PG8_SB(1, 1), b3 + hstep, voffB);
            PG8_WAIT_V(6); PG8_BAR; PG8_MMA(1, 1, At, B1); PG8_BAR;
            }
        }
        if constexpr (ALIGN_EPI) { if (wr == 0) PG8_BAR; }
        if constexpr (!Epi::AFTER_DRAIN) { E(acc, cur, wr, wc, fr, fq); S.done(cur); }
        if (!has_next) break;
#pragma unroll
        for (int a = 0; a < 2; ++a)
#pragma unroll
            for (int b = 0; b < 2; ++b)
#pragma unroll
                for (int m = 0; m < 4; ++m)
#pragma unroll
                    for (int n = 0; n < 2; ++n) acc[a][b][m][n] = (f32x4){0.f, 0.f, 0.f, 0.f};
        cur = nxt; cA = nA; cB = nB; ++ui;
        if constexpr (ALIGN_EPI) { if (wr == 1) PG8_BAR; }
    }
    PG8_WAIT_V(0);
    if constexpr (!ALIGN_EPI) { if (wr == 0) PG8_BAR; }
    PG8_BAR;
    if constexpr (Epi::AFTER_DRAIN) { E.fused(acc, cur, wr, wc, fr, fq, lds, wid, lane); S.done(cur); }
#undef PG8_SA
#undef PG8_SB
#undef PG8_STAGE
#undef PG8_LDA
#undef PG8_LDB
#undef PG8_MMA
#undef PG8_WAIT_V
#undef PG8_WAIT_L
#undef PG8_BAR
#undef PG8_SCHED
}
}
#define LAS __attribute__((address_space(3)))
typedef unsigned short bf16_t;
typedef short bf16x8 __attribute__((ext_vector_type(8)));
typedef float f32x4 __attribute__((ext_vector_type(4)));
typedef float f32x16 __attribute__((ext_vector_type(16)));
typedef unsigned u32x4 __attribute__((ext_vector_type(4)));
typedef unsigned u32x2 __attribute__((ext_vector_type(2)));
constexpr int DM = 2048, MT = 6144, DFF = 8192, NQKV = 4608, NREC = 4096;
constexpr size_t MiB = (size_t)1 << 20;
constexpr size_t WS_WQKV = 0, WS_WO = 18 * MiB, WS_WRIN = 26 * MiB, WS_WROUT = 42 * MiB, WS_W1 = 50 * MiB, WS_W2 = 114 * MiB, WS_WG = 178 * MiB,
                 WS_MOD = 180 * MiB, WS_ROPE = 181 * MiB, WS_CKA = 182 * MiB, WS_CVTA = 183 * MiB, WS_CKB = 184 * MiB, WS_CVTB = 184 * MiB + 512 * 1024,
                 WS_XN = 186 * MiB, WS_QKV = 210 * MiB, WS_VT = 264 * MiB, WS_AO = 280 * MiB, WS_O32 = 304 * MiB, WS_Y = 352 * MiB, WS_H = 400 * MiB,
                 WS_XRG = 400 * MiB, WS_HF = 448 * MiB, WS_END = 496 * MiB;
constexpr size_t MOD_BYTES = 2 * 3 * 12288 * 4;
constexpr int LDS_BYTES = 131072 + 4096;
constexpr int NPHASE = 16;

__device__ __forceinline__ int sigma_rope(int p) { const int wc = p >> 5, fq = (p >> 3) & 3, n = (p >> 2) & 1, i = p & 3; return 64 * (wc >> 1) + 32 * n + 16 * (wc & 1) + 4 * fq + i; }
__device__ __forceinline__ float silu_f(float x) { return x / (1.f + __expf(-x)); }
__device__ __forceinline__ float wave_sum(float v) {
#pragma unroll
    for (int o = 1; o < 64; o <<= 1) v += __shfl_xor(v, o);
    return v;
}

template <bool ROPEPERM>
__device__ __forceinline__ void tr_item(const float* __restrict__ W, int K, int N, bf16_t* __restrict__ WT, LAS float* scr, int item, int lane) {
    const int nblk = N / 32, kb = item / nblk, nb = item % nblk, k0 = 64 * kb, n0 = 32 * nb;
    int ncol = n0 + (lane & 31);
    if (ROPEPERM) { if (ncol >= 3072 && ncol < 4352) ncol = (ncol & ~127) + sigma_rope(ncol & 127); }
    const float* src = W + (size_t)(k0 + (lane >> 5)) * N + ncol;
    float v[32];
#pragma unroll
    for (int i = 0; i < 32; ++i) v[i] = __builtin_nontemporal_load(src + (size_t)(2 * i) * N);
#pragma unroll
    for (int i = 0; i < 32; ++i) scr[(2 * i + (lane >> 5)) * 33 + (lane & 31)] = v[i];
    asm volatile("s_waitcnt lgkmcnt(0)" ::: "memory");
    const int c = lane & 7;
#pragma unroll
    for (int j = 0; j < 4; ++j) { const int n = (lane >> 3) + 8 * j; const LAS float* s = scr + (8 * c) * 33 + n;
        u32x4 o; o.x = pk2(s[0 * 33], s[1 * 33]); o.y = pk2(s[2 * 33], s[3 * 33]); o.z = pk2(s[4 * 33], s[5 * 33]); o.w = pk2(s[6 * 33], s[7 * 33]);
        *(u32x4*)(WT + (size_t)(n0 + n) * K + k0 + 8 * c) = o; }
    asm volatile("s_waitcnt lgkmcnt(0)" ::: "memory");
}
__device__ __forceinline__ void ada_item(const float* __restrict__ w_ada, const float* __restrict__ b_ada, const float* __restrict__ c_ctx, const float* __restrict__ c_s, float* mod, LAS float* scr, int item, int lane) {
    const int kq = item & 7, cc = (item >> 3) % 96, l = item / 768;
    for (int i = lane; i < 768; i += 64) { const int ci = i >> 8, k = 256 * kq + (i & 255); const float x = (ci == 0) ? c_ctx[k] : c_s[(ci - 1) * 2048 + k]; scr[i] = silu_f(x); }
    asm volatile("s_waitcnt lgkmcnt(0)" ::: "memory");
    const int half = lane >> 5, n = 128 * cc + 4 * (lane & 31);
    const float* wp = w_ada + ((size_t)l * 2048 + 256 * kq + half) * 12288 + n;
    f32x4 a0 = {0.f, 0.f, 0.f, 0.f}, a1 = a0, a2 = a0;
#pragma unroll 1
    for (int i0 = 0; i0 < 128; i0 += 16) {
        f32x4 w[16];
#pragma unroll
        for (int i = 0; i < 16; ++i) w[i] = __builtin_nontemporal_load((const f32x4*)(wp + (size_t)(2 * (i0 + i)) * 12288));
#pragma unroll
        for (int i = 0; i < 16; ++i) { const int kk = 2 * (i0 + i) + half; a0 += w[i] * scr[kk]; a1 += w[i] * scr[256 + kk]; a2 += w[i] * scr[512 + kk]; }
    }
#pragma unroll
    for (int j = 0; j < 4; ++j) { a0[j] += __shfl_xor(a0[j], 32); a1[j] += __shfl_xor(a1[j], 32); a2[j] += __shfl_xor(a2[j], 32); }
    if (half == 0) {
        f32x4 b = {0.f, 0.f, 0.f, 0.f}; if (kq == 0) b = *(const f32x4*)(b_ada + (size_t)l * 12288 + n);
        float* m0 = mod + ((size_t)l * 3) * 12288 + n;
#pragma unroll
        for (int j = 0; j < 4; ++j) { atomicAdd(m0 + j, a0[j] + b[j]); atomicAdd(m0 + 12288 + j, a1[j] + b[j]); atomicAdd(m0 + 2 * 12288 + j, a2[j] + b[j]); }
    }
    asm volatile("s_waitcnt lgkmcnt(0)" ::: "memory");
}
struct P0Args { const float *w_att_in, *w_att_out, *w_rec_in, *w_rec_out, *w_ff1, *w_ff2, *w_rg_a, *w_rg_x, *w_ada, *b_ada, *c_ctx, *c_s, *cak, *cav, *cbk, *cbv; unsigned char* ws; };
__device__ __forceinline__ void tr_dispatch(const P0Args& A, LAS float* scr, int it, int lane) {
    unsigned char* ws = A.ws;
    if (it < 4608) { tr_item<true>(A.w_att_in, DM, NQKV, (bf16_t*)(ws + WS_WQKV), scr, it, lane); return; } it -= 4608;
    if (it < 2048) { tr_item<false>(A.w_att_out, DM, DM, (bf16_t*)(ws + WS_WO), scr, it, lane); return; } it -= 2048;
    if (it < 4096) { tr_item<false>(A.w_rec_in, DM, NREC, (bf16_t*)(ws + WS_WRIN), scr, it, lane); return; } it -= 4096;
    if (it < 2048) { tr_item<false>(A.w_rec_out, DM, DM, (bf16_t*)(ws + WS_WROUT), scr, it, lane); return; } it -= 2048;
    if (it < 16384) { const int l = it >> 13; tr_item<false>(A.w_ff1 + (size_t)l * DM * DFF, DM, DFF, (bf16_t*)(ws + WS_W1) + (size_t)l * DM * DFF, scr, it & 8191, lane); return; } it -= 16384;
    if (it < 16384) { const int l = it >> 13; tr_item<false>(A.w_ff2 + (size_t)l * DM * DFF, DFF, DM, (bf16_t*)(ws + WS_W2) + (size_t)l * DM * DFF, scr, it & 8191, lane); return; } it -= 16384;
    { const int mat = it >> 3, gate = mat >> 5, dn = mat & 31;
      const float* src = (gate ? A.w_rg_x : A.w_rg_a) + (size_t)dn * 16384;
      bf16_t* dst = (bf16_t*)(ws + WS_WG) + (size_t)(((dn >> 4) * 2 + gate) * 16 + (dn & 15)) * 16384;
      tr_item<false>(src, 128, 128, dst, scr, it & 7, lane); }
}
constexpr int N_TR_ITEMS = 4608 + 2048 + 4096 + 2048 + 16384 + 16384 + 512;
constexpr int N_ADA_ITEMS = 1536;
__device__ __forceinline__ void p0_prologue(const P0Args& A, LAS unsigned char* lds, int G, int bid, int tid) {
    const int wave = __builtin_amdgcn_readfirstlane(tid >> 6), lane = tid & 63;
    LAS float* scr = (LAS float*)(lds + wave * 8704);
    const int gw = bid * 8 + wave, NGW = G * 8;
    {
        unsigned char* ws = A.ws; const int gt = bid * 512 + tid, NT = G * 512;
        bf16_t* cKa = (bf16_t*)(ws + WS_CKA); bf16_t* cVta = (bf16_t*)(ws + WS_CVTA); bf16_t* cKb = (bf16_t*)(ws + WS_CKB); bf16_t* cVtb = (bf16_t*)(ws + WS_CVTB); float* rope = (float*)(ws + WS_ROPE);
        for (int i = gt; i < 524288; i += NT) { cKa[i] = (bf16_t)(pk2(A.cak[i], 0.f) & 0xffffu);
            const int b = i >> 18, t = (i >> 10) & 255, c = i & 1023; cVta[((size_t)b * 1024 + c) * 256 + t] = (bf16_t)(pk2(A.cav[i], 0.f) & 0xffffu); }
        for (int i = gt; i < 131072; i += NT) { const int b = i >> 16, t = (i >> 8) & 255, c = i & 255;
            cKb[i] = (bf16_t)(pk2(A.cbk[(i & ~127) + sigma_rope(i & 127)], 0.f) & 0xffffu);
            cVtb[((size_t)b * 256 + c) * 256 + t] = (bf16_t)(pk2(A.cbv[i], 0.f) & 0xffffu); }
        for (int i = gt; i < 2048; i += NT) { const int pos = i >> 5, e = i & 31; const float inv = powf(10000.f, -(float)e / 32.f); const float ang = (float)pos * inv; rope[2 * i] = cosf(ang); rope[2 * i + 1] = sinf(ang); }
    }
    for (int it = gw; it < N_ADA_ITEMS; it += NGW) ada_item(A.w_ada, A.b_ada, A.c_ctx, A.c_s, (float*)(A.ws + WS_MOD), scr, it, lane);
    if (NGW == 2048) {
        if (gw >= 1536) for (int i = 0; i < 16; ++i) tr_dispatch(A, scr, (gw - 1536) + 512 * i, lane);
        for (int it = 8192 + gw; it < N_TR_ITEMS; it += NGW) tr_dispatch(A, scr, it, lane);
    } else {
        for (int it = gw; it < N_TR_ITEMS; it += NGW) tr_dispatch(A, scr, it, lane);
    }
}

__device__ __forceinline__ void norm_row(const float* __restrict__ resid, const float* __restrict__ o, const float* __restrict__ gate, const float* __restrict__ gpost,
                                         float* yout, const float* __restrict__ gnext, const float* __restrict__ sc, const float* __restrict__ sh, bf16_t* xn, int lane) {
    f32x4 y[8];
#pragma unroll
    for (int j = 0; j < 8; ++j) y[j] = *(const f32x4*)(resid + 4 * lane + 256 * j);
    if (o) {
        f32x4 ov[8]; float s = 0.f;
#pragma unroll
        for (int j = 0; j < 8; ++j) { ov[j] = *(const f32x4*)(o + 4 * lane + 256 * j); s += (ov[j][0] * ov[j][0] + ov[j][1] * ov[j][1]) + (ov[j][2] * ov[j][2] + ov[j][3] * ov[j][3]); }
        const float rstd = 1.f / sqrtf(wave_sum(s) * (1.f / DM) + 1e-6f);
#pragma unroll
        for (int j = 0; j < 8; ++j) { const f32x4 g = *(const f32x4*)(gate + 4 * lane + 256 * j), gp = *(const f32x4*)(gpost + 4 * lane + 256 * j); y[j] = y[j] + g * (ov[j] * rstd * gp); }
    }
    if (yout) {
#pragma unroll
        for (int j = 0; j < 8; ++j) *(f32x4*)(yout + 4 * lane + 256 * j) = y[j];
    }
    if (xn) {
        float s = 0.f;
#pragma unroll
        for (int j = 0; j < 8; ++j) s += (y[j][0] * y[j][0] + y[j][1] * y[j][1]) + (y[j][2] * y[j][2] + y[j][3] * y[j][3]);
        const float rstd = 1.f / sqrtf(wave_sum(s) * (1.f / DM) + 1e-6f);
#pragma unroll
        for (int j = 0; j < 8; ++j) { const f32x4 gn = *(const f32x4*)(gnext + 4 * lane + 256 * j), s1 = *(const f32x4*)(sc + 4 * lane + 256 * j), s0 = *(const f32x4*)(sh + 4 * lane + 256 * j);
            const f32x4 h = y[j] * rstd * gn * (s1 + 1.f) + s0; u32x2 w; w.x = pk2(h[0], h[1]); w.y = pk2(h[2], h[3]); *(u32x2*)(xn + 4 * lane + 256 * j) = w; }
    }
}

struct AttnSt { f32x16 o[4]; float m, l; };
__device__ __forceinline__ int pi32(int i) { return (i & ~12) | ((i & 4) << 1) | ((i & 8) >> 1); }
template <int MODE>
__device__ __forceinline__ void attn_tile(AttnSt& st, const bf16x8 (&qf)[8], const bf16_t* __restrict__ kp, const bf16_t* __restrict__ vp, size_t vblk, int hi, int a0, int a1, const float* __restrict__ rp) {
    bf16x8 kf[8], vf[4][2];
#pragma unroll
    for (int d0 = 0; d0 < 8; ++d0) kf[d0] = *(const bf16x8*)(kp + 16 * d0);
#pragma unroll
    for (int db = 0; db < 4; ++db)
#pragma unroll
        for (int s2 = 0; s2 < 2; ++s2) vf[db][s2] = *(const bf16x8*)(vp + db * vblk + 16 * s2);
    f32x16 s = {0.f, 0.f, 0.f, 0.f, 0.f, 0.f, 0.f, 0.f, 0.f, 0.f, 0.f, 0.f, 0.f, 0.f, 0.f, 0.f};
#pragma unroll
    for (int d0 = 0; d0 < 8; ++d0) s = __builtin_amdgcn_mfma_f32_32x32x16_bf16(kf[d0], qf[d0], s, 0, 0, 0);
    constexpr float LOG2E = 1.4426950408889634f, SC = 0.08838834764831845f * LOG2E;
    float t[16]; float mx = -1e30f;
#pragma unroll
    for (int r = 0; r < 16; ++r) { const int kl = (r & 7) + 8 * hi + 16 * (r >> 3); float v = s[r] * SC;
        if (MODE == 1) { const int kc = a0 + kl, j = a1; const int sc0 = min(max(j - 8, 0), 48); const bool valid = (kc >= sc0) && (kc < sc0 + 16); const int dc = min(max(kc - j + 15, 0), 30);
            const float bias = rp[dc]; v = valid ? v + bias * LOG2E : -1e30f; }
        if (MODE == 2) { const int d = a1 - (a0 + kl); v = (d <= 128 && d >= -128) ? v : -1e30f; }
        t[r] = v; mx = fmaxf(mx, v); }
    mx = fmaxf(mx, __shfl_xor(mx, 32));
    const float mnew = fmaxf(st.m, mx), alpha = __builtin_amdgcn_exp2f(st.m - mnew); st.m = mnew;
    float ps = 0.f;
#pragma unroll
    for (int r = 0; r < 16; ++r) { t[r] = __builtin_amdgcn_exp2f(t[r] - mnew); ps += t[r]; }
    st.l = st.l * alpha + ps;
#pragma unroll
    for (int db = 0; db < 4; ++db) st.o[db] = st.o[db] * alpha;
    bf16x8 pf[2];
#pragma unroll
    for (int s2 = 0; s2 < 2; ++s2) { u32x4 w; w.x = pk2(t[8 * s2 + 0], t[8 * s2 + 1]); w.y = pk2(t[8 * s2 + 2], t[8 * s2 + 3]); w.z = pk2(t[8 * s2 + 4], t[8 * s2 + 5]); w.w = pk2(t[8 * s2 + 6], t[8 * s2 + 7]); pf[s2] = __builtin_bit_cast(bf16x8, w); }
#pragma unroll
    for (int db = 0; db < 4; ++db)
#pragma unroll
        for (int s2 = 0; s2 < 2; ++s2) st.o[db] = __builtin_amdgcn_mfma_f32_32x32x16_bf16(vf[db][s2], pf[s2], st.o[db], 0, 0, 0);
}
__device__ __forceinline__ void attn_init(AttnSt& st) {
#pragma unroll
    for (int db = 0; db < 4; ++db)
#pragma unroll
        for (int r = 0; r < 16; ++r) st.o[db][r] = 0.f;
    st.m = -1e30f; st.l = 0.f;
}
__device__ __forceinline__ void attn_finish(AttnSt& st, bf16_t* orow, int hi, float sinkl2) {
    float l = st.l + __shfl_xor(st.l, 32);
    l += __builtin_amdgcn_exp2f(sinkl2 - st.m);
    const float inv = 1.f / l;
#pragma unroll
    for (int db = 0; db < 4; ++db)
#pragma unroll
        for (int rg = 0; rg < 4; ++rg) { u32x2 w; w.x = pk2(st.o[db][4 * rg] * inv, st.o[db][4 * rg + 1] * inv); w.y = pk2(st.o[db][4 * rg + 2] * inv, st.o[db][4 * rg + 3] * inv);
            *(u32x2*)(orow + db * 32 + 8 * rg + 4 * hi) = w; }
}
__device__ __forceinline__ void load_q(bf16x8 (&qf)[8], const bf16_t* __restrict__ qp) {
#pragma unroll
    for (int d0 = 0; d0 < 8; ++d0) qf[d0] = *(const bf16x8*)(qp + 16 * d0);
}
struct AttnArgs { const bf16_t *QKV, *VT, *cKa, *cVta, *cKb, *cVtb; bf16_t* AO; const float *sink, *rpb; };
__device__ __forceinline__ void attn_prompt_unit(const AttnArgs& A, int pu, int lane) {
    const int r32 = lane & 31, hi = lane >> 5, qb = pu & 7, h16 = (pu >> 3) & 15, b = pu >> 7;
    const bool isb = h16 >= 8; const int hq = h16 - 8;
    const int qcol = isb ? 3072 + hq * 128 : h16 * 128, kcol = isb ? 4096 + (hq >> 2) * 128 : 1024 + h16 * 128, vrow = isb ? 1024 + (hq >> 2) * 128 : h16 * 128, ocol = isb ? 1024 + hq * 128 : h16 * 128;
    const int row = b * 256 + qb * 32 + r32;
    bf16x8 qf[8]; load_q(qf, A.QKV + (size_t)row * NQKV + qcol + 8 * hi);
    AttnSt st; attn_init(st);
    const bf16_t* kp = A.QKV + (size_t)(b * 256 + pi32(r32)) * NQKV + kcol + 8 * hi;
    const bf16_t* vp = A.VT + (size_t)(vrow + r32) * MT + b * 256 + 8 * hi;
#pragma unroll 1
    for (int kt = 0; kt < 8; ++kt) attn_tile<0>(st, qf, kp + (size_t)kt * 32 * NQKV, vp + kt * 32, (size_t)32 * MT, hi, 0, 0, nullptr);
    attn_finish(st, A.AO + (size_t)row * DM + ocol, hi, isb ? A.sink[hq] * 1.4426950408889634f : -1e30f);
}
__device__ __forceinline__ void attn_na_unit(const AttnArgs& A, int u, int lane) {
    const int r32 = lane & 31, hi = lane >> 5, qb = u & 31, h = (u >> 5) & 7, b = u >> 8;
    const int rq = qb >> 1, jq0 = (qb & 1) * 32, tokbase = 4096 + b * 1024;
    const int row = tokbase + rq * 64 + jq0 + r32;
    bf16x8 qf[8]; load_q(qf, A.QKV + (size_t)row * NQKV + h * 128 + 8 * hi);
    AttnSt st; attn_init(st);
    { const bf16_t* kp = A.cKa + (size_t)(b * 256 + pi32(r32)) * 1024 + h * 128 + 8 * hi; const bf16_t* vp = A.cVta + (size_t)(b * 1024 + h * 128 + r32) * 256 + 8 * hi;
#pragma unroll 1
      for (int kt = 0; kt < 8; ++kt) attn_tile<0>(st, qf, kp + (size_t)kt * 32 * 1024, vp + kt * 32, (size_t)32 * 256, hi, 0, 0, nullptr); }
    const int r0 = min(max(rq - 4, 0), 8);
    const bf16_t* kp = A.QKV + (size_t)(tokbase + pi32(r32)) * NQKV + 1024 + h * 128 + 8 * hi; const bf16_t* vp = A.VT + (size_t)(h * 128 + r32) * MT + tokbase + 8 * hi;
#pragma unroll 1
    for (int i = 0; i < 16; ++i) { const int kr = r0 + (i >> 1), ch = i & 1, tok = kr * 64 + ch * 32;
        attn_tile<1>(st, qf, kp + (size_t)tok * NQKV, vp + tok, (size_t)32 * MT, hi, ch * 32, jq0 + r32, A.rpb + (h * 15 + (kr - rq + 7)) * 31); }
    attn_finish(st, A.AO + (size_t)row * DM + h * 128, hi, -1e30f);
}
__device__ __forceinline__ void attn_win_unit(const AttnArgs& A, int u, int lane) {
    const int r32 = lane & 31, hi = lane >> 5, qb = u & 31, hq = (u >> 5) & 7, b = u >> 8, kvh = hq >> 2;
    const int tokbase = 4096 + b * 1024, q0 = qb * 32, row = tokbase + q0 + r32;
    bf16x8 qf[8]; load_q(qf, A.QKV + (size_t)row * NQKV + 3072 + hq * 128 + 8 * hi);
    AttnSt st; attn_init(st);
    { const bf16_t* kp = A.cKb + (size_t)(b * 256 + pi32(r32)) * 256 + kvh * 128 + 8 * hi; const bf16_t* vp = A.cVtb + (size_t)(b * 256 + kvh * 128 + r32) * 256 + 8 * hi;
#pragma unroll 1
      for (int kt = 0; kt < 8; ++kt) attn_tile<0>(st, qf, kp + (size_t)kt * 32 * 256, vp + kt * 32, (size_t)32 * 256, hi, 0, 0, nullptr); }
    const bf16_t* kp = A.QKV + (size_t)(tokbase + pi32(r32)) * NQKV + 4096 + kvh * 128 + 8 * hi; const bf16_t* vp = A.VT + (size_t)(1024 + kvh * 128 + r32) * MT + tokbase + 8 * hi;
    const int k0 = max(qb - 4, 0), k1 = min(qb + 4, 31);
#pragma unroll 1
    for (int kt = k0; kt <= k1; ++kt) attn_tile<2>(st, qf, kp + (size_t)kt * 32 * NQKV, vp + kt * 32, (size_t)32 * MT, hi, kt * 32, q0 + r32, nullptr);
    attn_finish(st, A.AO + (size_t)row * DM + 1024 + hq * 128, hi, A.sink[hq] * 1.4426950408889634f);
}
__device__ __forceinline__ void attn_phase(const AttnArgs& A, int G, int bid, int tid) {
    const int wave = __builtin_amdgcn_readfirstlane(tid >> 6), lane = tid & 63, gw = bid * 8 + wave, NGW = G * 8;
    for (int u = gw; u < 2048; u += NGW) {
        if (u < 512) attn_na_unit(A, u, lane);
        else if (u < 1024) attn_win_unit(A, u - 512, lane);
        else { attn_prompt_unit(A, 2 * (u - 1024), lane); attn_prompt_unit(A, 2 * (u - 1024) + 1, lane); }
    }
}

struct ScanArgs { const bf16_t* XRG; float* HF; bf16_t* YR; const bf16_t* WG; const float *conv_w, *conv_b, *b_a, *b_x, *lam, *st_f, *st_b; float* out; };
__device__ __forceinline__ float gelu_tanh(float x) { const float u = 0.7978845608028654f * (x + 0.044715f * x * x * x); const float e = __expf(2.f * u); const float th = 1.f - 2.f / (e + 1.f); return 0.5f * x * (1.f + th); }
__device__ __forceinline__ void scan_unit(const ScanArgs& A, LAS unsigned char* lds, int s, int n, int tid) {
    const int wave = __builtin_amdgcn_readfirstlane(tid >> 6), lane = tid & 63, r32_ = lane & 31, hi_ = lane >> 5, r32 = r32_, hi = hi_;
    const int T = (s < 16) ? 256 : 1024, row0 = (s < 16) ? s * 256 : 4096 + (s - 16) * 1024, c0 = n * 128, NC = T / 64;
    LAS unsigned char* Abf = lds;
    LAS float* XC = (LAS float*)(lds + 17408);
    LAS float* AA = (LAS float*)(lds + 50176);
    LAS float* BB = (LAS float*)(lds + 82944);
    LAS float* SEGA = (LAS float*)(lds + 115712);
    LAS float* SEGB = SEGA + 512;
    LAS float* CAR = (LAS float*)(lds + 119808);
    const int cq_ = tid & 31, tg_ = tid >> 5, cq = cq_, tg = tg_;
    const int cb = wave & 3, rt = wave >> 2;
    const int sc_c_ = tid & 127, sg_ = tid >> 7;
    f32x4 cw[4];
#pragma unroll
    for (int k = 0; k < 4; ++k) cw[k] = *(const f32x4*)(A.conv_w + k * 2048 + c0 + 4 * cq);
    const f32x4 cbv = *(const f32x4*)(A.conv_b + c0 + 4 * cq);
    const bf16_t* xbase0 = A.XRG + (size_t)row0 * NREC + c0;
#pragma unroll 1
    for (int dir = 0; dir < 2; ++dir) {
        const bf16_t* wgp0 = A.WG + ((size_t)((dir * 2 + 0) * 16 + n) * 128 + 32 * cb) * 128;
        const int jc = dir * 2048 + c0 + 32 * cb + r32;
        const float ba = A.b_a[jc], bx = A.b_x[jc], sp = log1pf(__expf(-A.lam[jc]));
        __syncthreads();
        if (tid < 128) { float cv = 0.f; if (s >= 16) { const float vf = A.st_f[(s - 16) * 2048 + c0 + tid], vb = A.st_b[(s - 16) * 2048 + c0 + tid]; cv = dir ? vb : vf; } CAR[tid] = cv; }
        u32x2 xraw[7];
        { const bf16_t* xbase = xbase0 + 4 * cq; const int cc = dir ? NC - 1 : 0, tb = cc * 64 + 4 * tg - 2;
#pragma unroll
          for (int i = 0; i < 7; ++i) { const int t = tb + i; xraw[i] = (t >= 0 && t < T) ? *(const u32x2*)(xbase + (size_t)t * NREC) : (u32x2){0u, 0u}; } }
#pragma unroll 1
        for (int ci = 0; ci < NC; ++ci) {
            const int cc = dir ? NC - 1 - ci : ci, t0 = cc * 64;
            int cq = cq_, tg = tg_, r32 = r32_, hi = hi_, sc_c = sc_c_, sg = sg_;
            asm volatile("" : "+v"(cq), "+v"(tg), "+v"(r32), "+v"(hi), "+v"(sc_c), "+v"(sg));
            {
                f32x4 xf[7];
#pragma unroll
                for (int i = 0; i < 7; ++i) xf[i] = (f32x4){bf2f((unsigned short)(xraw[i].x & 0xffffu)), bf2f((unsigned short)(xraw[i].x >> 16)), bf2f((unsigned short)(xraw[i].y & 0xffffu)), bf2f((unsigned short)(xraw[i].y >> 16))};
#pragma unroll
                for (int tt = 0; tt < 4; ++tt) { f32x4 v = cbv;
#pragma unroll
                    for (int k = 0; k < 4; ++k) v += cw[k] * xf[tt + k];
                    const int t = 4 * tg + tt;
                    *(LAS f32x4*)(XC + t * 128 + 4 * cq) = v;
                    u32x2 w; w.x = pk2(v[0], v[1]); w.y = pk2(v[2], v[3]); *(LAS u32x2*)(Abf + t * 272 + 8 * cq) = w; }
            }
            if (ci + 1 < NC) { const bf16_t* xbase = xbase0 + 4 * cq; const int cn = dir ? NC - 2 - ci : ci + 1, tb = cn * 64 + 4 * tg - 2;
#pragma unroll
                for (int i = 0; i < 7; ++i) { const int t = tb + i; xraw[i] = (t >= 0 && t < T) ? *(const u32x2*)(xbase + (size_t)t * NREC) : (u32x2){0u, 0u}; } }
            f32x4 hf4[4]; u32x2 g4[4];
            if (dir) {
#pragma unroll
                for (int tt = 0; tt < 4; ++tt) { const size_t r = (size_t)(row0 + t0 + 4 * tg + tt); hf4[tt] = *(const f32x4*)(A.HF + r * DM + c0 + 4 * cq); g4[tt] = *(const u32x2*)(A.XRG + r * NREC + 2048 + c0 + 4 * cq); }
            }
            bf16x8 wa[8], wx[8]; const bf16_t* wgp = wgp0 + r32 * 128 + 8 * hi;
#pragma unroll
            for (int ks = 0; ks < 8; ++ks) { wa[ks] = *(const bf16x8*)(wgp + 16 * ks); wx[ks] = *(const bf16x8*)(wgp + (size_t)16 * 16384 + 16 * ks); }
            __syncthreads();
            {
                f32x16 ga = {0.f, 0.f, 0.f, 0.f, 0.f, 0.f, 0.f, 0.f, 0.f, 0.f, 0.f, 0.f, 0.f, 0.f, 0.f, 0.f}, gx = ga;
#pragma unroll
                for (int ks = 0; ks < 8; ++ks) { const bf16x8 af = *(const LAS bf16x8*)(Abf + (32 * rt + r32) * 272 + (16 * ks + 8 * hi) * 2);
                    ga = __builtin_amdgcn_mfma_f32_32x32x16_bf16(af, wa[ks], ga, 0, 0, 0); gx = __builtin_amdgcn_mfma_f32_32x32x16_bf16(af, wx[ks], gx, 0, 0, 0); }
#pragma unroll
                for (int r = 0; r < 16; ++r) { const int t = 32 * rt + (r & 3) + 8 * (r >> 2) + 4 * hi, j = 32 * cb + r32;
                    const float rr = 1.f / (1.f + __expf(-(ga[r] + ba))), ii = 1.f / (1.f + __expf(-(gx[r] + bx)));
                    const float la = -8.f * rr * sp, a = __expf(la), mult = sqrtf(-expm1f(2.f * la));
                    AA[t * 128 + j] = a; BB[t * 128 + j] = mult * ii * XC[t * 128 + j]; }
            }
            __syncthreads();
            {
                float av[16], bv[16]; float Aacc = 1.f, Bacc = 0.f;
#pragma unroll
                for (int k = 0; k < 16; ++k) { const int uu = 16 * sg + k, t = dir ? 63 - uu : uu; av[k] = AA[t * 128 + sc_c]; bv[k] = BB[t * 128 + sc_c]; Bacc = av[k] * Bacc + bv[k]; Aacc *= av[k]; }
                SEGA[sg * 128 + sc_c] = Aacc; SEGB[sg * 128 + sc_c] = Bacc;
                __syncthreads();
                float h = CAR[(ci & 1) * 128 + sc_c];
                for (int s2 = 0; s2 < sg; ++s2) h = SEGA[s2 * 128 + sc_c] * h + SEGB[s2 * 128 + sc_c];
#pragma unroll
                for (int k = 0; k < 16; ++k) { const int uu = 16 * sg + k, t = dir ? 63 - uu : uu; h = av[k] * h + bv[k]; BB[t * 128 + sc_c] = h; }
                if (sg == 3) { CAR[((ci + 1) & 1) * 128 + sc_c] = h;
                    if (ci == NC - 1 && s < 16) A.out[(dir ? OUT_RB : OUT_RF) + s * 2048 + c0 + sc_c] = h; }
            }
            __syncthreads();
#pragma unroll
            for (int tt = 0; tt < 4; ++tt) { const int t = 4 * tg + tt; const size_t r = (size_t)(row0 + t0 + t); const f32x4 hv = *(const LAS f32x4*)(BB + t * 128 + 4 * cq);
                if (!dir) *(f32x4*)(A.HF + r * DM + c0 + 4 * cq) = hv;
                else { const f32x4 sum = hv + hf4[tt];
                    const float g0 = gelu_tanh(bf2f((unsigned short)(g4[tt].x & 0xffffu))), g1 = gelu_tanh(bf2f((unsigned short)(g4[tt].x >> 16))), g2 = gelu_tanh(bf2f((unsigned short)(g4[tt].y & 0xffffu))), g3 = gelu_tanh(bf2f((unsigned short)(g4[tt].y >> 16)));
                    u32x2 w; w.x = pk2(sum[0] * g0, sum[1] * g1); w.y = pk2(sum[2] * g2, sum[3] * g3); *(u32x2*)(A.YR + r * DM + c0 + 4 * cq) = w; } }
        }
    }
    __syncthreads();
}
__device__ __forceinline__ void scan_phase(const ScanArgs& A, LAS unsigned char* lds, int G, int bid, int tid) {
#pragma unroll 1
    for (int i = 0;; ++i) {
        int u;
        if (G == 256) { if (i == 0) u = bid; else if (i == 1 && bid >= 32 && bid < 64) u = 256 + bid - 32; else break; }
        else { u = bid + i * G; if (u >= 288) break; }
        const int s = (u < 32) ? 16 + (u >> 4) : (u - 32) >> 4, n = (u < 32) ? (u & 15) : ((u - 32) & 15);
        scan_unit(A, lds, s, n, tid);
    }
}

struct Params { const float* in[31]; float* out; unsigned char* ws; int ph_lo, ph_hi; };
__global__ void __launch_bounds__(512, 2) mega_fwd(Params P) {
    extern __shared__ __attribute__((aligned(16))) unsigned char lds_raw[];
    LAS unsigned char* lds = (LAS unsigned char*)lds_raw;
    const int tid = threadIdx.x, G = gridDim.x, bid = blockIdx.x;
    const int wave = __builtin_amdgcn_readfirstlane(tid >> 6), lane = tid & 63;
    unsigned char* ws = P.ws;
    const int lo = P.ph_lo, hi = P.ph_hi;
    bf16_t* XN = (bf16_t*)(ws + WS_XN); bf16_t* QKV = (bf16_t*)(ws + WS_QKV); bf16_t* VT = (bf16_t*)(ws + WS_VT); bf16_t* AO = (bf16_t*)(ws + WS_AO);
    float* O32 = (float*)(ws + WS_O32); float* Y = (float*)(ws + WS_Y); bf16_t* H = (bf16_t*)(ws + WS_H); bf16_t* XRG = (bf16_t*)(ws + WS_XRG); float* HF = (float*)(ws + WS_HF);
    const float* mod = (const float*)(ws + WS_MOD);
    const float *g_pre_mix = P.in[12], *g_post_mix = P.in[13], *g_pre_ffn = P.in[14], *g_post_ffn = P.in[15];
#ifndef PH_MASK
#define PH_MASK 0xFFFF
#endif
#define IN(k) ((((PH_MASK) >> (k)) & 1) && lo <= (k) && (k) < hi)
#define SEAM(k) do { if (IN(k) && IN((k) + 1)) { cg::this_grid().sync(); } } while (0)
#define MODP(l, ci, ch) (mod + ((size_t)((l) * 3 + (ci)) * 6 + (ch)) * 2048)
    if (IN(0)) {
        P0Args A{P.in[16], P.in[17], P.in[20], P.in[28], P.in[29], P.in[30], P.in[23], P.in[25], P.in[10], P.in[11], P.in[9], P.in[2], P.in[3], P.in[4], P.in[5], P.in[6], ws};
        p0_prologue(A, lds, G, bid, tid);
    }
    SEAM(0);
    if (IN(1)) {
        for (int m = bid * 8 + wave; m < MT; m += G * 8) { const int ci = (m < 4096) ? 0 : 1 + ((m - 4096) >> 10);
            const float* x = (m < 4096) ? P.in[0] + (size_t)m * DM : P.in[1] + (size_t)(m - 4096) * DM;
            norm_row(x, nullptr, nullptr, nullptr, nullptr, g_pre_mix, MODP(0, ci, 1), MODP(0, ci, 0), XN + (size_t)m * DM, lane); }
    }
    SEAM(1);
    if (IN(2)) {
        pg8::Gemm g{XN, (const bf16_t*)(ws + WS_WQKV), MT, NQKV, DM}; pg8::StaticOrder S; S.init(MT, NQKV, G, bid);
        pg8::EpiQKV E{QKV, VT, P.out, (const float*)(ws + WS_ROPE)};
        pg8::gemm_phase<pg8::EpiQKV, pg8::StaticOrder, true, true>(lds, g, S, E);
    }
    SEAM(2);
    if (IN(3)) {
        AttnArgs A{QKV, VT, (const bf16_t*)(ws + WS_CKA), (const bf16_t*)(ws + WS_CVTA), (const bf16_t*)(ws + WS_CKB), (const bf16_t*)(ws + WS_CVTB), AO, P.in[18], P.in[19]};
        attn_phase(A, G, bid, tid);
    }
    SEAM(3);
    if (IN(4)) {
        pg8::Gemm g{AO, (const bf16_t*)(ws + WS_WO), MT, DM, DM}; pg8::StaticOrder S; S.init(MT, DM, G, bid);
        pg8::EpiF32 E{O32, DM};
        pg8::gemm_phase<pg8::EpiF32, pg8::StaticOrder, true, true>(lds, g, S, E);
    }
    SEAM(4);
    if (IN(5)) {
        for (int m = bid * 8 + wave; m < MT; m += G * 8) { const int ci = (m < 4096) ? 0 : 1 + ((m - 4096) >> 10);
            const float* x = (m < 4096) ? P.in[0] + (size_t)m * DM : P.in[1] + (size_t)(m - 4096) * DM;
            norm_row(x, O32 + (size_t)m * DM, MODP(0, ci, 2), g_post_mix, Y + (size_t)m * DM, g_pre_ffn, MODP(0, ci, 4), MODP(0, ci, 3), XN + (size_t)m * DM, lane); }
    }
    SEAM(5);
    if (IN(6)) {
        pg8::Gemm g{XN, (const bf16_t*)(ws + WS_W1), MT, DFF, DM}; pg8::StaticOrder S; S.init(MT, DFF, G, bid);
        pg8::EpiBf16<2> E{H, DFF};
        pg8::gemm_phase<pg8::EpiBf16<2>, pg8::StaticOrder, true, true>(lds, g, S, E);
    }
    SEAM(6);
    if (IN(7)) {
        pg8::Gemm g{H, (const bf16_t*)(ws + WS_W2), MT, DM, DFF}; pg8::StaticOrder S; S.init(MT, DM, G, bid);
        pg8::EpiF32 E{O32, DM};
        pg8::gemm_phase<pg8::EpiF32, pg8::StaticOrder, true, true>(lds, g, S, E);
    }
    SEAM(7);
    if (IN(8)) {
        for (int m = bid * 8 + wave; m < MT; m += G * 8) { const int ci = (m < 4096) ? 0 : 1 + ((m - 4096) >> 10);
            norm_row(Y + (size_t)m * DM, O32 + (size_t)m * DM, MODP(0, ci, 5), g_post_ffn, Y + (size_t)m * DM, g_pre_mix + DM, MODP(1, ci, 1), MODP(1, ci, 0), XN + (size_t)m * DM, lane); }
    }
    SEAM(8);
    if (IN(9)) {
        pg8::Gemm g{XN, (const bf16_t*)(ws + WS_WRIN), MT, NREC, DM}; pg8::StaticOrder S; S.init(MT, NREC, G, bid);
        pg8::EpiBf16<0> E{XRG, NREC};
        pg8::gemm_phase<pg8::EpiBf16<0>, pg8::StaticOrder, true, true>(lds, g, S, E);
    }
    SEAM(9);
    if (IN(10)) {
        ScanArgs A{XRG, HF, AO, (const bf16_t*)(ws + WS_WG), P.in[21], P.in[22], P.in[24], P.in[26], P.in[27], P.in[7], P.in[8], P.out};
        scan_phase(A, lds, G, bid, tid);
    }
    SEAM(10);
    if (IN(11)) {
        pg8::Gemm g{AO, (const bf16_t*)(ws + WS_WROUT), MT, DM, DM}; pg8::StaticOrder S; S.init(MT, DM, G, bid);
        pg8::EpiF32 E{O32, DM};
        pg8::gemm_phase<pg8::EpiF32, pg8::StaticOrder, true, true>(lds, g, S, E);
    }
    SEAM(11);
    if (IN(12)) {
        for (int m = bid * 8 + wave; m < MT; m += G * 8) { const int ci = (m < 4096) ? 0 : 1 + ((m - 4096) >> 10);
            norm_row(Y + (size_t)m * DM, O32 + (size_t)m * DM, MODP(1, ci, 2), g_post_mix + DM, Y + (size_t)m * DM, g_pre_ffn + DM, MODP(1, ci, 4), MODP(1, ci, 3), XN + (size_t)m * DM, lane); }
    }
    SEAM(12);
    if (IN(13)) {
        pg8::Gemm g{XN, (const bf16_t*)(ws + WS_W1) + (size_t)DM * DFF, MT, DFF, DM}; pg8::StaticOrder S; S.init(MT, DFF, G, bid);
        pg8::EpiBf16<2> E{H, DFF};
        pg8::gemm_phase<pg8::EpiBf16<2>, pg8::StaticOrder, true, true>(lds, g, S, E);
    }
    SEAM(13);
    if (IN(14)) {
        pg8::Gemm g{H, (const bf16_t*)(ws + WS_W2) + (size_t)DM * DFF, MT, DM, DFF}; pg8::StaticOrder S; S.init(MT, DM, G, bid);
        pg8::EpiF32 E{O32, DM};
        pg8::gemm_phase<pg8::EpiF32, pg8::StaticOrder, true, true>(lds, g, S, E);
    }
    SEAM(14);
    if (IN(15)) {
        for (int m = bid * 8 + wave; m < MT; m += G * 8) { const int ci = (m < 4096) ? 0 : 1 + ((m - 4096) >> 10);
            norm_row(Y + (size_t)m * DM, O32 + (size_t)m * DM, MODP(1, ci, 5), g_post_ffn + DM, P.out + (size_t)m * DM, nullptr, nullptr, nullptr, nullptr, lane); }
    }
#undef IN
#undef SEAM
#undef MODP
}

#ifndef MK_MULTI
#define MK_MULTI 0
#endif
extern "C" void kernel_launch(void* const* d_in, const int* in_sizes, int n_in, void* d_out, int out_size, void* d_ws, size_t ws_size, hipStream_t stream) {
    static int grid = 0;
    if (grid == 0) {
        if (n_in != 31 || ws_size < WS_END) { fprintf(stderr, "kernel_launch: unexpected n_in %d / ws %zu\n", n_in, ws_size); grid = -1; return; }
        int dev = 0, cus = 0, per_cu = 0;
        (void)hipGetDevice(&dev); (void)hipDeviceGetAttribute(&cus, hipDeviceAttributeMultiprocessorCount, dev);
        (void)hipFuncSetAttribute((const void*)mega_fwd, hipFuncAttributeMaxDynamicSharedMemorySize, LDS_BYTES);
        (void)hipOccupancyMaxActiveBlocksPerMultiprocessor(&per_cu, (const void*)mega_fwd, 512, LDS_BYTES);
        if (per_cu < 1) per_cu = 1;
        grid = cus * 1;
        if (grid <= 0) grid = 256;
        (void)hipGetLastError();
    }
    if (grid < 0) return;
    (void)hipMemsetAsync((char*)d_ws + WS_MOD, 0, MOD_BYTES, stream);
    Params p{};
    for (int i = 0; i < 31; ++i) p.in[i] = (const float*)d_in[i];
    p.out = (float*)d_out; p.ws = (unsigned char*)d_ws;
#if MK_MULTI
    for (int ph = 0; ph < NPHASE; ++ph) { p.ph_lo = ph; p.ph_hi = ph + 1; hipLaunchKernelGGL(mega_fwd, dim3(grid), dim3(512), LDS_BYTES, stream, p); }
#else
    p.ph_lo = 0; p.ph_hi = NPHASE;
    void* args[] = {&p};
    hipError_t e = hipLaunchCooperativeKernel((const void*)mega_fwd, dim3(grid), dim3(512), args, LDS_BYTES, stream);
    if (e != hipSuccess) fprintf(stderr, "cooperative launch failed: %s (grid %d)\n", hipGetErrorString(e), grid);
#endif
}
```

```cpp
#include <hip/hip_runtime.h>
#include <hip/hip_cooperative_groups.h>
#include <cstdio>
#include <cstdint>
namespace cg = cooperative_groups;

constexpr int OUT_YP = 0, OUT_YS = 8388608, OUT_AK = 12582912, OUT_AV = 16777216, OUT_BK = 20971520, OUT_BV = 22020096, OUT_RF = 23068672, OUT_RB = 23101440;
typedef float f32x2_t __attribute__((ext_vector_type(2)));
typedef __bf16 bf16x2_t __attribute__((ext_vector_type(2)));
__device__ __forceinline__ unsigned pk2(float lo, float hi) { f32x2_t v = {lo, hi}; bf16x2_t b = __builtin_convertvector(v, bf16x2_t); return __builtin_bit_cast(unsigned, b); }
__device__ __forceinline__ float bf2f(unsigned short h) { return __builtin_bit_cast(float, (unsigned)h << 16); }
namespace pg8 {
#define PG8_LAS __attribute__((address_space(3)))
typedef unsigned short bf16_t;
typedef short bf16x8 __attribute__((ext_vector_type(8)));
typedef float f32x4 __attribute__((ext_vector_type(4)));
typedef unsigned u32x4 __attribute__((ext_vector_type(4)));
constexpr int BM = 256, BK = 64, HALF = 128, HTB = HALF * BK * 2  , STAGE_BYTES = 8 * HTB, NXCD = 8, WGM = 8;

__host__ __device__ __forceinline__ int lds_byte(int r, int c) { const int st = (r >> 4) * 2 + (c >> 5), rr = r & 15, cc = c & 31, ob = rr * 64 + cc * 2; return st * 1024 + (ob ^ (((ob >> 9) & 1) << 5)); }
__host__ __device__ __forceinline__ void stage_rc(int b, int& R, int& C) { const int st = b / 1024, sb = b % 1024, swz = sb ^ (((sb >> 9) & 1) << 5); R = (st >> 1) * 16 + swz / 64; C = (st & 1) * 32 + (swz % 64) / 2; }
__host__ __device__ __forceinline__ int perm32(int rho) { const int n = rho >> 4, i = rho & 15; return 8 * (i >> 2) + 4 * n + (i & 3); }

struct Unit { int pm, pn; };
struct Gemm { const bf16_t* A; const bf16_t* Bt; int M, N, K; };

struct StaticOrder {
    int nM, nN, nwg, G, c, rep;
    __host__ __device__ void init(int M, int N, int G_, int c_) { nM = M / BM; nN = N / BM; nwg = nM * nN; G = G_; c = c_; rep = 1; }
    __host__ __device__ bool next(int i, Unit& u) const {
        long L = (long)i * G + c; if (L >= (long)nwg * rep) return false; L %= nwg;
        int wgid = (int)L; { const int q = nwg / NXCD, r = nwg % NXCD, xcd = wgid % NXCD, off = wgid / NXCD; wgid = (xcd < r ? xcd * (q + 1) : r * (q + 1) + (xcd - r) * q) + off; }
        const int nig = WGM * nN, gid = wgid / nig, fm = gid * WGM, gsz = (nM - fm) < WGM ? (nM - fm) : WGM;
        u.pm = fm + ((wgid % nig) % gsz); u.pn = (wgid % nig) / gsz; return true;
    }
    __device__ __forceinline__ void a_ready(const Unit&) const {}
    __device__ __forceinline__ void done(const Unit&) const {}
};

struct EpiF32 {
    static constexpr bool PERM = false, AFTER_DRAIN = false;
    float* O; int ldc;
    __device__ __forceinline__ void operator()(const f32x4 (&acc)[2][2][4][2], const Unit& u, int wr, int wc, int fr, int fq) const {
        const int row0 = u.pm * BM + wr * 64 + fr, col0 = u.pn * BM + wc * 32 + 4 * fq;
#pragma unroll
        for (int ai = 0; ai < 2; ++ai)
#pragma unroll
            for (int m = 0; m < 4; ++m) { float* rowp = O + (size_t)(row0 + ai * HALF + m * 16) * ldc + col0;
#pragma unroll
                for (int bj = 0; bj < 2; ++bj)
#pragma unroll
                    for (int n = 0; n < 2; ++n) *(f32x4*)(rowp + bj * HALF + n * 16) = acc[ai][bj][m][n]; }
    }
};
template <int ACT  > struct EpiBf16 {
    static constexpr bool PERM = true, AFTER_DRAIN = false;
    bf16_t* O; int ldc;
    __device__ __forceinline__ void operator()(const f32x4 (&acc)[2][2][4][2], const Unit& u, int wr, int wc, int fr, int fq) const {
        const int row0 = u.pm * BM + wr * 64 + fr, col0 = u.pn * BM + wc * 32 + 8 * fq;
#pragma unroll
        for (int ai = 0; ai < 2; ++ai)
#pragma unroll
            for (int m = 0; m < 4; ++m) { bf16_t* rowp = O + (size_t)(row0 + ai * HALF + m * 16) * ldc + col0;
#pragma unroll
                for (int bj = 0; bj < 2; ++bj) { f32x4 v0 = acc[ai][bj][m][0], v1 = acc[ai][bj][m][1];
                    if (ACT == 2) {
#pragma unroll
                        for (int i = 0; i < 4; ++i) { const float a = fmaxf(v0[i], 0.f), b = fmaxf(v1[i], 0.f); v0[i] = a * a; v1[i] = b * b; } }
                    u32x4 w; w.x = pk2(v0[0], v0[1]); w.y = pk2(v0[2], v0[3]); w.z = pk2(v1[0], v1[1]); w.w = pk2(v1[2], v1[3]);
                    *(u32x4*)(rowp + bj * HALF) = w; } }
    }
};
struct EpiQKV {
    static constexpr bool PERM = true, AFTER_DRAIN = false;
    bf16_t* QKV; bf16_t* VT; float* out; const float* rope;
    __device__ __forceinline__ void operator()(const f32x4 (&acc)[2][2][4][2], const Unit& u, int wr, int wc, int fr, int fq) const {
        const int pn = u.pn, pm = u.pm; const bool prompt = pm < 16;
        const int row0 = pm * BM + wr * 64 + fr, colp = wc * 32 + 8 * fq;
        if ((pn >= 8 && pn < 12) || pn == 17) {
            const bool isb = (pn == 17);
            const int vcol0 = isb ? 1024 : (pn - 8) * 256;
            float* of = out + (isb ? OUT_BV : OUT_AV); const int ldo = isb ? 256 : 1024, ocol0 = isb ? 0 : (pn - 8) * 256;
#pragma unroll
            for (int ai = 0; ai < 2; ++ai)
#pragma unroll
                for (int m = 0; m < 4; ++m) { const int row = row0 + ai * HALF + m * 16;
#pragma unroll
                    for (int bj = 0; bj < 2; ++bj) { const f32x4 v0 = acc[ai][bj][m][0], v1 = acc[ai][bj][m][1]; const int c = bj * HALF + colp;
                        bf16_t* vp = VT + (size_t)(vcol0 + c) * 6144 + row;
                        const unsigned w0 = pk2(v0[0], v0[1]), w1 = pk2(v0[2], v0[3]), w2 = pk2(v1[0], v1[1]), w3 = pk2(v1[2], v1[3]);
                        vp[0 * 6144] = (bf16_t)(w0 & 0xffffu); vp[1 * 6144] = (bf16_t)(w0 >> 16); vp[2 * 6144] = (bf16_t)(w1 & 0xffffu); vp[3 * 6144] = (bf16_t)(w1 >> 16);
                        vp[4 * 6144] = (bf16_t)(w2 & 0xffffu); vp[5 * 6144] = (bf16_t)(w2 >> 16); vp[6 * 6144] = (bf16_t)(w3 & 0xffffu); vp[7 * 6144] = (bf16_t)(w3 >> 16);
                        if (prompt) { float* op = of + (size_t)row * ldo + ocol0 + c; *(f32x4*)op = v0; *(f32x4*)(op + 4) = v1; } } }
        } else {
            const bool ropeT = (pn >= 12) && !prompt;
            const bool isKA = (pn >= 4 && pn < 8) && prompt, isKB = (pn == 16) && prompt;
            const int e0 = 16 * (wc & 1) + 4 * fq, dlog = 64 * (wc >> 1) + e0;
#pragma unroll
            for (int ai = 0; ai < 2; ++ai)
#pragma unroll
                for (int m = 0; m < 4; ++m) { const int row = row0 + ai * HALF + m * 16;
                    f32x4 cs = {1.f, 1.f, 1.f, 1.f}, sn = {0.f, 0.f, 0.f, 0.f};
                    if (ropeT) { const int t = (row - 4096) & 1023; const int pos = (wc >> 1) ? (t & 63) : (t >> 6);
                        const f32x4 a = *(const f32x4*)(rope + (size_t)(pos * 32 + e0) * 2), b = *(const f32x4*)(rope + (size_t)(pos * 32 + e0) * 2 + 4);
                        cs = (f32x4){a[0], a[2], b[0], b[2]}; sn = (f32x4){a[1], a[3], b[1], b[3]}; }
#pragma unroll
                    for (int bj = 0; bj < 2; ++bj) { f32x4 v0 = acc[ai][bj][m][0], v1 = acc[ai][bj][m][1];
                        if (ropeT) { const f32x4 o0 = v0 * cs - v1 * sn, o1 = v1 * cs + v0 * sn; v0 = o0; v1 = o1; }
                        u32x4 w; w.x = pk2(v0[0], v0[1]); w.y = pk2(v0[2], v0[3]); w.z = pk2(v1[0], v1[1]); w.w = pk2(v1[2], v1[3]);
                        *(u32x4*)(QKV + (size_t)row * 4608 + pn * BM + bj * HALF + colp) = w;
                        if (isKA) { float* op = out + OUT_AK + (size_t)row * 1024 + (pn - 4) * 256 + bj * HALF + colp; *(f32x4*)op = v0; *(f32x4*)(op + 4) = v1; }
                        if (isKB) { float* op = out + OUT_BK + (size_t)row * 256 + bj * HALF + dlog; *(f32x4*)op = v0; *(f32x4*)(op + 32) = v1; } } }
        }
    }
};
template <class Epi, class Sched, bool ALIGN_EPI = false, bool SP2 = false>
__device__ __forceinline__ void gemm_phase(PG8_LAS unsigned char* lds, const Gemm g, const Sched& S, const Epi& E) {
    const int tid = threadIdx.x, wid = __builtin_amdgcn_readfirstlane(tid >> 6), lane = tid & 63, wr = wid >> 2, wc = wid & 3, fr = lane & 15, fq = lane >> 4;
    const int K = g.K, nt = K / BK;
    unsigned voffA[2], voffB[2];
#pragma unroll
    for (int i = 0; i < 2; ++i) { int R, C; stage_rc(tid * 16 + i * 8192, R, C); const int Rb = Epi::PERM ? ((R & ~31) + perm32(R & 31)) : R;
        voffA[i] = (unsigned)(R * K + C) * 2u; voffB[i] = (unsigned)(Rb * K + C) * 2u; }
    const size_t kstep = (size_t)(BK * 2);
    const size_t hstep = (size_t)HALF * K * 2;
    const size_t tstep = 2 * hstep;
    const unsigned ldsw = (unsigned)wid * 1024u;
    const int aoff = lds_byte(wr * 64 + fr, fq * 8), boff = lds_byte(wc * 32 + fr, fq * 8);
#define PG8_SA(b, h) (((b) * 2 + (h)) * HTB)
#define PG8_SB(b, h) ((4 + (b) * 2 + (h)) * HTB)
#define PG8_STAGE(bufoff, gbase, voff) do { _Pragma("unroll") for (int _i = 0; _i < 2; ++_i) \
        __builtin_amdgcn_global_load_lds((const unsigned*)((const char*)(gbase) + (voff)[_i]), (PG8_LAS unsigned*)(lds + (bufoff) + ldsw + _i * 8192), 16, 0, 0); } while (0)
#define PG8_LDA(dst, b, h) do { _Pragma("unroll") for (int m = 0; m < 4; ++m) _Pragma("unroll") for (int k = 0; k < 2; ++k) dst[m][k] = *(const PG8_LAS bf16x8*)(lds + PG8_SA(b, h) + aoff + m * 2048 + k * 1024); } while (0)
#define PG8_LDB(dst, b, h) do { _Pragma("unroll") for (int n = 0; n < 2; ++n) _Pragma("unroll") for (int k = 0; k < 2; ++k) dst[n][k] = *(const PG8_LAS bf16x8*)(lds + PG8_SB(b, h) + boff + n * 2048 + k * 1024); } while (0)
#define PG8_MMA(ai, bj, At, Bt) do { __builtin_amdgcn_s_setprio(1); _Pragma("unroll") for (int m = 0; m < 4; ++m) _Pragma("unroll") for (int n = 0; n < 2; ++n) _Pragma("unroll") for (int k = 0; k < 2; ++k) \
        acc[ai][bj][m][n] = __builtin_amdgcn_mfma_f32_16x16x32_bf16(Bt[n][k], At[m][k], acc[ai][bj][m][n], 0, 0, 0); __builtin_amdgcn_s_setprio(0); } while (0)
#define PG8_WAIT_V(n) asm volatile("s_waitcnt vmcnt(" #n ")" ::: "memory")
#define PG8_WAIT_L(n) asm volatile("s_waitcnt lgkmcnt(" #n ")" ::: "memory")
#define PG8_BAR __builtin_amdgcn_s_barrier()
#define PG8_SCHED __builtin_amdgcn_sched_barrier(0)
    Unit cur, nxt; int ui = 0;
    if (!S.next(0, cur)) return;
    f32x4 acc[2][2][4][2];
#pragma unroll
    for (int a = 0; a < 2; ++a)
#pragma unroll
        for (int b = 0; b < 2; ++b)
#pragma unroll
            for (int m = 0; m < 4; ++m)
#pragma unroll
                for (int n = 0; n < 2; ++n) acc[a][b][m][n] = (f32x4){0.f, 0.f, 0.f, 0.f};
    bf16x8 At[4][2], B0[2][2], B1[2][2];
    const char* cA = (const char*)g.A + (size_t)cur.pm * tstep; const char* cB = (const char*)g.Bt + (size_t)cur.pn * tstep;
    S.a_ready(cur);
    if constexpr (SP2) {
        PG8_STAGE(PG8_SB(0, 0), cB, voffB); PG8_STAGE(PG8_SB(0, 1), cB + hstep, voffB); PG8_STAGE(PG8_SA(0, 0), cA, voffA); PG8_STAGE(PG8_SA(0, 1), cA + hstep, voffA);
        if (wr == 1) PG8_BAR;
        PG8_WAIT_V(2); PG8_BAR;
        PG8_STAGE(PG8_SB(1, 0), cB + kstep, voffB); PG8_STAGE(PG8_SA(1, 0), cA + kstep, voffA); PG8_STAGE(PG8_SB(1, 1), cB + hstep + kstep, voffB);
        PG8_WAIT_V(6); PG8_BAR;
    } else {
        PG8_STAGE(PG8_SB(0, 0), cB, voffB); PG8_STAGE(PG8_SA(0, 0), cA, voffA); PG8_STAGE(PG8_SB(0, 1), cB + hstep, voffB); PG8_STAGE(PG8_SA(0, 1), cA + hstep, voffA);
        if (wr == 1) PG8_BAR;
        PG8_WAIT_V(4); PG8_BAR;
        PG8_STAGE(PG8_SB(1, 0), cB + kstep, voffB); PG8_STAGE(PG8_SA(1, 0), cA + kstep, voffA); PG8_STAGE(PG8_SB(1, 1), cB + hstep + kstep, voffB);
        PG8_WAIT_V(6); PG8_BAR;
    }
    for (;;) {
        const bool has_next = S.next(ui + 1, nxt);
        const char* nA = has_next ? (const char*)g.A + (size_t)nxt.pm * tstep : cA; const char* nB = has_next ? (const char*)g.Bt + (size_t)nxt.pn * tstep : cB;
        for (int t = 0; t < nt; t += 2) {
            const bool last = (t == nt - 2);
            const char* a1 = cA + (size_t)(t + 1) * kstep;
            const char* a2 = last ? nA : cA + (size_t)(t + 2) * kstep; const char* b2 = last ? nB : cB + (size_t)(t + 2) * kstep;
            const char* a3 = a2 + kstep; const char* b3 = b2 + kstep;
            if (last && has_next) S.a_ready(nxt);
            if constexpr (SP2) {
            PG8_LDB(B0, 0, 0); PG8_LDB(B1, 0, 1); PG8_SCHED; PG8_LDA(At, 0, 0); PG8_STAGE(PG8_SA(1, 1), a1 + hstep, voffA);
            PG8_WAIT_V(8); PG8_WAIT_L(0); PG8_BAR; PG8_MMA(0, 0, At, B0); PG8_MMA(0, 1, At, B1); PG8_BAR; PG8_SCHED;
            PG8_LDA(At, 0, 1); PG8_STAGE(PG8_SB(0, 0), b2, voffB); PG8_STAGE(PG8_SB(0, 1), b2 + hstep, voffB); PG8_STAGE(PG8_SA(0, 0), a2, voffA);
            PG8_WAIT_V(8); PG8_WAIT_L(0); PG8_BAR; PG8_MMA(1, 0, At, B0); PG8_MMA(1, 1, At, B1); PG8_BAR; PG8_SCHED;
            PG8_LDB(B0, 1, 0); PG8_LDB(B1, 1, 1); PG8_SCHED; PG8_LDA(At, 1, 0); PG8_STAGE(PG8_SA(0, 1), a2 + hstep, voffA);
            PG8_WAIT_V(8); PG8_WAIT_L(0); PG8_BAR; PG8_MMA(0, 0, At, B0); PG8_MMA(0, 1, At, B1); PG8_BAR; PG8_SCHED;
            PG8_LDA(At, 1, 1); PG8_STAGE(PG8_SB(1, 0), b3, voffB); PG8_STAGE(PG8_SB(1, 1), b3 + hstep, voffB); PG8_STAGE(PG8_SA(1, 0), a3, voffA);
            PG8_WAIT_V(8); PG8_WAIT_L(0); PG8_BAR; PG8_MMA(1, 0, At, B0); PG8_MMA(1, 1, At, B1); PG8_BAR; PG8_SCHED;
            } else {
            PG8_LDB(B0, 0, 0); PG8_SCHED; PG8_LDA(At, 0, 0); PG8_STAGE(PG8_SA(1, 1), a1 + hstep, voffA);
            PG8_WAIT_L(8); PG8_BAR; PG8_WAIT_L(0); PG8_MMA(0, 0, At, B0); PG8_BAR; PG8_SCHED;
            PG8_LDB(B1, 0, 1); PG8_STAGE(PG8_SB(0, 0), b2, voffB);
            PG8_BAR; PG8_WAIT_L(0); PG8_MMA(0, 1, At, B1); PG8_BAR;
            PG8_LDA(At, 0, 1); PG8_STAGE(PG8_SA(0, 0), a2, voffA);
            PG8_BAR; PG8_WAIT_L(0); PG8_MMA(1, 0, At, B0); PG8_BAR; PG8_SCHED;
            PG8_STAGE(PG8_SB(0, 1), b2 + hstep, voffB);
            PG8_WAIT_V(6); PG8_BAR; PG8_MMA(1, 1, At, B1); PG8_BAR;
            PG8_LDB(B0, 1, 0); PG8_SCHED; PG8_LDA(At, 1, 0); PG8_STAGE(PG8_SA(0, 1), a2 + hstep, voffA);
            PG8_WAIT_L(8); PG8_BAR; PG8_WAIT_L(0); PG8_MMA(0, 0, At, B0); PG8_BAR; PG8_SCHED;
            PG8_LDB(B1, 1, 1); PG8_STAGE(PG8_SB(1, 0), b3, voffB);
            PG8_BAR; PG8_WAIT_L(0); PG8_MMA(0, 1, At, B1); PG8_BAR;
            PG8_LDA(At, 1, 1); PG8_STAGE(PG8_SA(1, 0), a3, voffA);
            PG8_BAR; PG8_WAIT_L(0); PG8_MMA(1, 0, At, B0); PG8_BAR; PG8_SCHED;
            PG8_STAGE(PG8_SB(1, 1), b3 + hstep, voffB);
            PG8_WAIT_V(6); PG8_BAR; PG8_MMA(1, 1, At, B1); PG8_BAR;
            }
        }
        if constexpr (ALIGN_EPI) { if (wr == 0) PG8_BAR; }
        if constexpr (!Epi::AFTER_DRAIN) { E(acc, cur, wr, wc, fr, fq); S.done(cur); }
        if (!has_next) break;
#pragma unroll
        for (int a = 0; a < 2; ++a)
#pragma unroll
            for (int b = 0; b < 2; ++b)
#pragma unroll
                for (int m = 0; m < 4; ++m)
#pragma unroll
                    for (int n = 0; n < 2; ++n) acc[a][b][m][n] = (f32x4){0.f, 0.f, 0.f, 0.f};
        cur = nxt; cA = nA; cB = nB; ++ui;
        if constexpr (ALIGN_EPI) { if (wr == 1) PG8_BAR; }
    }
    PG8_WAIT_V(0);
    if constexpr (!ALIGN_EPI) { if (wr == 0) PG8_BAR; }
    PG8_BAR;
    if constexpr (Epi::AFTER_DRAIN) { E.fused(acc, cur, wr, wc, fr, fq, lds, wid, lane); S.done(cur); }
#undef PG8_SA
#undef PG8_SB
#undef PG8_STAGE
#undef PG8_LDA
#undef PG8_LDB
#undef PG8_MMA
#undef PG8_WAIT_V
#undef PG8_WAIT_L
#undef PG8_BAR
#undef PG8_SCHED
}
}
#ifndef REP_MASK
#define REP_MASK 0
#endif
#define LAS __attribute__((address_space(3)))
typedef unsigned short bf16_t;
typedef short bf16x8 __attribute__((ext_vector_type(8)));
typedef float f32x4 __attribute__((ext_vector_type(4)));
typedef float f32x16 __attribute__((ext_vector_type(16)));
typedef unsigned u32x4 __attribute__((ext_vector_type(4)));
typedef unsigned u32x2 __attribute__((ext_vector_type(2)));
constexpr int DM = 2048, MT = 6144, DFF = 8192, NQKV = 4608, NREC = 4096;
constexpr size_t MiB = (size_t)1 << 20;
constexpr size_t WS_WQKV = 0, WS_WO = 18 * MiB, WS_WRIN = 26 * MiB, WS_WROUT = 42 * MiB, WS_W1 = 50 * MiB, WS_W2 = 114 * MiB, WS_WG = 178 * MiB,
                 WS_MOD = 180 * MiB, WS_ROPE = 181 * MiB, WS_CKA = 182 * MiB, WS_CVTA = 183 * MiB, WS_CKB = 184 * MiB, WS_CVTB = 184 * MiB + 512 * 1024,
                 WS_XN = 186 * MiB, WS_QKV = 210 * MiB, WS_VT = 264 * MiB, WS_AO = 280 * MiB, WS_O32 = 304 * MiB, WS_Y = 352 * MiB, WS_H = 400 * MiB,
                 WS_XRG = 400 * MiB, WS_HF = 448 * MiB, WS_END = 496 * MiB;
constexpr size_t MOD_BYTES = 2 * 3 * 12288 * 4;
constexpr size_t WS_BAR = WS_MOD + 512 * 1024, CTL_ZERO_BYTES = 512 * 1024 + 16384;
constexpr int LDS_BYTES = 131072 + 4096;
constexpr int NPHASE = 16;

__device__ __forceinline__ int sigma_rope(int p) { const int wc = p >> 5, fq = (p >> 3) & 3, n = (p >> 2) & 1, i = p & 3; return 64 * (wc >> 1) + 32 * n + 16 * (wc & 1) + 4 * fq + i; }
__device__ __forceinline__ float silu_f(float x) { return x / (1.f + __expf(-x)); }
__device__ __forceinline__ float wave_sum(float v) {
#pragma unroll
    for (int o = 1; o < 64; o <<= 1) v += __shfl_xor(v, o);
    return v;
}

template <bool ROPEPERM>
__device__ __forceinline__ void tr_item(const float* __restrict__ W, int K, int N, bf16_t* __restrict__ WT, LAS float* scr, int item, int lane) {
    const int nblk = N / 32, kb = item / nblk, nb = item % nblk, k0 = 64 * kb, n0 = 32 * nb;
    int ncol = n0 + (lane & 31);
    if (ROPEPERM) { if (ncol >= 3072 && ncol < 4352) ncol = (ncol & ~127) + sigma_rope(ncol & 127); }
    const float* src = W + (size_t)(k0 + (lane >> 5)) * N + ncol;
    float v[32];
#pragma unroll
    for (int i = 0; i < 32; ++i) v[i] = __builtin_nontemporal_load(src + (size_t)(2 * i) * N);
#pragma unroll
    for (int i = 0; i < 32; ++i) scr[(2 * i + (lane >> 5)) * 33 + (lane & 31)] = v[i];
    asm volatile("s_waitcnt lgkmcnt(0)" ::: "memory");
    const int c = lane & 7;
#pragma unroll
    for (int j = 0; j < 4; ++j) { const int n = (lane >> 3) + 8 * j; const LAS float* s = scr + (8 * c) * 33 + n;
        u32x4 o; o.x = pk2(s[0 * 33], s[1 * 33]); o.y = pk2(s[2 * 33], s[3 * 33]); o.z = pk2(s[4 * 33], s[5 * 33]); o.w = pk2(s[6 * 33], s[7 * 33]);
        *(u32x4*)(WT + (size_t)(n0 + n) * K + k0 + 8 * c) = o; }
    asm volatile("s_waitcnt lgkmcnt(0)" ::: "memory");
}
__device__ __forceinline__ void ada_item(const float* __restrict__ w_ada, const float* __restrict__ b_ada, const float* __restrict__ c_ctx, const float* __restrict__ c_s, float* mod, LAS float* scr, int item, int lane) {
    const int kq = item & 7, cc = (item >> 3) % 96, l = item / 768;
    for (int i = lane; i < 768; i += 64) { const int ci = i >> 8, k = 256 * kq + (i & 255); const float x = (ci == 0) ? c_ctx[k] : c_s[(ci - 1) * 2048 + k]; scr[i] = silu_f(x); }
    asm volatile("s_waitcnt lgkmcnt(0)" ::: "memory");
    const int half = lane >> 5, n = 128 * cc + 4 * (lane & 31);
    const float* wp = w_ada + ((size_t)l * 2048 + 256 * kq + half) * 12288 + n;
    f32x4 a0 = {0.f, 0.f, 0.f, 0.f}, a1 = a0, a2 = a0;
#pragma unroll 1
    for (int i0 = 0; i0 < 128; i0 += 16) {
        f32x4 w[16];
#pragma unroll
        for (int i = 0; i < 16; ++i) w[i] = __builtin_nontemporal_load((const f32x4*)(wp + (size_t)(2 * (i0 + i)) * 12288));
#pragma unroll
        for (int i = 0; i < 16; ++i) { const int kk = 2 * (i0 + i) + half; a0 += w[i] * scr[kk]; a1 += w[i] * scr[256 + kk]; a2 += w[i] * scr[512 + kk]; }
    }
#pragma unroll
    for (int j = 0; j < 4; ++j) { a0[j] += __shfl_xor(a0[j], 32); a1[j] += __shfl_xor(a1[j], 32); a2[j] += __shfl_xor(a2[j], 32); }
    if (half == 0) {
        f32x4 b = {0.f, 0.f, 0.f, 0.f}; if (kq == 0) b = *(const f32x4*)(b_ada + (size_t)l * 12288 + n);
        float* m0 = mod + ((size_t)l * 3) * 12288 + n;
#pragma unroll
        for (int j = 0; j < 4; ++j) { atomicAdd(m0 + j, a0[j] + b[j]); atomicAdd(m0 + 12288 + j, a1[j] + b[j]); atomicAdd(m0 + 2 * 12288 + j, a2[j] + b[j]); }
    }
    asm volatile("s_waitcnt lgkmcnt(0)" ::: "memory");
}
struct P0Args { const float *w_att_in, *w_att_out, *w_rec_in, *w_rec_out, *w_ff1, *w_ff2, *w_rg_a, *w_rg_x, *w_ada, *b_ada, *c_ctx, *c_s, *cak, *cav, *cbk, *cbv; unsigned char* ws; };
__device__ __forceinline__ void tr_dispatch(const P0Args& A, LAS float* scr, int it, int lane) {
    unsigned char* ws = A.ws;
    if (it < 4608) { tr_item<true>(A.w_att_in, DM, NQKV, (bf16_t*)(ws + WS_WQKV), scr, it, lane); return; } it -= 4608;
    if (it < 2048) { tr_item<false>(A.w_att_out, DM, DM, (bf16_t*)(ws + WS_WO), scr, it, lane); return; } it -= 2048;
    if (it < 4096) { tr_item<false>(A.w_rec_in, DM, NREC, (bf16_t*)(ws + WS_WRIN), scr, it, lane); return; } it -= 4096;
    if (it < 2048) { tr_item<false>(A.w_rec_out, DM, DM, (bf16_t*)(ws + WS_WROUT), scr, it, lane); return; } it -= 2048;
    if (it < 16384) { const int l = it >> 13; tr_item<false>(A.w_ff1 + (size_t)l * DM * DFF, DM, DFF, (bf16_t*)(ws + WS_W1) + (size_t)l * DM * DFF, scr, it & 8191, lane); return; } it -= 16384;
    if (it < 16384) { const int l = it >> 13; tr_item<false>(A.w_ff2 + (size_t)l * DM * DFF, DFF, DM, (bf16_t*)(ws + WS_W2) + (size_t)l * DM * DFF, scr, it & 8191, lane); return; } it -= 16384;
    { const int mat = it >> 3, gate = mat >> 5, dn = mat & 31;
      const float* src = (gate ? A.w_rg_x : A.w_rg_a) + (size_t)dn * 16384;
      bf16_t* dst = (bf16_t*)(ws + WS_WG) + (size_t)(((dn >> 4) * 2 + gate) * 16 + (dn & 15)) * 16384;
      tr_item<false>(src, 128, 128, dst, scr, it & 7, lane); }
}
constexpr int N_TR_ITEMS = 4608 + 2048 + 4096 + 2048 + 16384 + 16384 + 512;
constexpr int N_ADA_ITEMS = 1536;
__device__ __forceinline__ void p0_prologue(const P0Args& A, LAS unsigned char* lds, int G, int bid, int tid) {
    const int wave = __builtin_amdgcn_readfirstlane(tid >> 6), lane = tid & 63;
    LAS float* scr = (LAS float*)(lds + wave * 8704);
    const int gw = bid * 8 + wave, NGW = G * 8;
    {
        unsigned char* ws = A.ws; const int gt = bid * 512 + tid, NT = G * 512;
        bf16_t* cKa = (bf16_t*)(ws + WS_CKA); bf16_t* cVta = (bf16_t*)(ws + WS_CVTA); bf16_t* cKb = (bf16_t*)(ws + WS_CKB); bf16_t* cVtb = (bf16_t*)(ws + WS_CVTB); float* rope = (float*)(ws + WS_ROPE);
        for (int i = gt; i < 524288; i += NT) { cKa[i] = (bf16_t)(pk2(A.cak[i], 0.f) & 0xffffu);
            const int b = i >> 18, t = (i >> 10) & 255, c = i & 1023; cVta[((size_t)b * 1024 + c) * 256 + t] = (bf16_t)(pk2(A.cav[i], 0.f) & 0xffffu); }
        for (int i = gt; i < 131072; i += NT) { const int b = i >> 16, t = (i >> 8) & 255, c = i & 255;
            cKb[i] = (bf16_t)(pk2(A.cbk[(i & ~127) + sigma_rope(i & 127)], 0.f) & 0xffffu);
            cVtb[((size_t)b * 256 + c) * 256 + t] = (bf16_t)(pk2(A.cbv[i], 0.f) & 0xffffu); }
        for (int i = gt; i < 2048; i += NT) { const int pos = i >> 5, e = i & 31; const float inv = powf(10000.f, -(float)e / 32.f); const float ang = (float)pos * inv; rope[2 * i] = cosf(ang); rope[2 * i + 1] = sinf(ang); }
    }
    for (int it = gw; it < N_ADA_ITEMS; it += NGW) ada_item(A.w_ada, A.b_ada, A.c_ctx, A.c_s, (float*)(A.ws + WS_MOD), scr, it, lane);
    for (int trrep = 0; trrep < 1 + (((REP_MASK) >> 16) & 1); ++trrep)
    if (NGW == 2048) {
        if (gw >= 1536) for (int i = 0; i < 16; ++i) tr_dispatch(A, scr, (gw - 1536) + 512 * i, lane);
        for (int it = 8192 + gw; it < N_TR_ITEMS; it += NGW) tr_dispatch(A, scr, it, lane);
    } else {
        for (int it = gw; it < N_TR_ITEMS; it += NGW) tr_dispatch(A, scr, it, lane);
    }
}

__device__ __forceinline__ void norm_row(const float* __restrict__ resid, const float* __restrict__ o, const float* __restrict__ gate, const float* __restrict__ gpost,
                                         float* yout, const float* __restrict__ gnext, const float* __restrict__ sc, const float* __restrict__ sh, bf16_t* xn, int lane) {
    f32x4 y[8];
#pragma unroll
    for (int j = 0; j < 8; ++j) y[j] = *(const f32x4*)(resid + 4 * lane + 256 * j);
    if (o) {
        f32x4 ov[8]; float s = 0.f;
#pragma unroll
        for (int j = 0; j < 8; ++j) { ov[j] = *(const f32x4*)(o + 4 * lane + 256 * j); s += (ov[j][0] * ov[j][0] + ov[j][1] * ov[j][1]) + (ov[j][2] * ov[j][2] + ov[j][3] * ov[j][3]); }
        const float rstd = 1.f / sqrtf(wave_sum(s) * (1.f / DM) + 1e-6f);
        asm volatile("" ::: "memory");
#pragma unroll
        for (int j = 0; j < 8; ++j) { const f32x4 g = *(const f32x4*)(gate + 4 * lane + 256 * j), gp = *(const f32x4*)(gpost + 4 * lane + 256 * j); y[j] = y[j] + g * (ov[j] * rstd * gp); }
    }
    if (yout) {
#pragma unroll
        for (int j = 0; j < 8; ++j) *(f32x4*)(yout + 4 * lane + 256 * j) = y[j];
    }
    if (xn) {
        float s = 0.f;
#pragma unroll
        for (int j = 0; j < 8; ++j) s += (y[j][0] * y[j][0] + y[j][1] * y[j][1]) + (y[j][2] * y[j][2] + y[j][3] * y[j][3]);
        const float rstd = 1.f / sqrtf(wave_sum(s) * (1.f / DM) + 1e-6f);
        asm volatile("" ::: "memory");
#pragma unroll
        for (int j = 0; j < 8; ++j) { const f32x4 gn = *(const f32x4*)(gnext + 4 * lane + 256 * j), s1 = *(const f32x4*)(sc + 4 * lane + 256 * j), s0 = *(const f32x4*)(sh + 4 * lane + 256 * j);
            const f32x4 h = y[j] * rstd * gn * (s1 + 1.f) + s0; u32x2 w; w.x = pk2(h[0], h[1]); w.y = pk2(h[2], h[3]); *(u32x2*)(xn + 4 * lane + 256 * j) = w; }
    }
}

struct AttnSt { f32x16 o[4]; float m, l; };
__device__ __forceinline__ int pi32(int i) { return (i & ~12) | ((i & 4) << 1) | ((i & 8) >> 1); }
template <int MODE>
__device__ __forceinline__ void attn_tile(AttnSt& st, const bf16x8 (&qf)[8], const bf16_t* __restrict__ kp, const bf16_t* __restrict__ vp, size_t vblk, int hi, int a0, int a1, const float* __restrict__ rp) {
    bf16x8 kf[8], vf[4][2];
#pragma unroll
    for (int d0 = 0; d0 < 8; ++d0) kf[d0] = *(const bf16x8*)(kp + 16 * d0);
#pragma unroll
    for (int db = 0; db < 4; ++db)
#pragma unroll
        for (int s2 = 0; s2 < 2; ++s2) vf[db][s2] = *(const bf16x8*)(vp + db * vblk + 16 * s2);
    f32x16 s = {0.f, 0.f, 0.f, 0.f, 0.f, 0.f, 0.f, 0.f, 0.f, 0.f, 0.f, 0.f, 0.f, 0.f, 0.f, 0.f};
#pragma unroll
    for (int d0 = 0; d0 < 8; ++d0) s = __builtin_amdgcn_mfma_f32_32x32x16_bf16(kf[d0], qf[d0], s, 0, 0, 0);
    constexpr float LOG2E = 1.4426950408889634f, SC = 0.08838834764831845f * LOG2E;
    float t[16]; float mx = -1e30f;
#pragma unroll
    for (int r = 0; r < 16; ++r) { const int kl = (r & 7) + 8 * hi + 16 * (r >> 3); float v = s[r] * SC;
        if (MODE == 1) { const int kc = a0 + kl, j = a1; const int sc0 = min(max(j - 8, 0), 48); const bool valid = (kc >= sc0) && (kc < sc0 + 16); const int dc = min(max(kc - j + 15, 0), 30);
            const float bias = rp[dc]; v = valid ? v + bias * LOG2E : -1e30f; }
        if (MODE == 2) { const int d = a1 - (a0 + kl); v = (d <= 128 && d >= -128) ? v : -1e30f; }
        t[r] = v; mx = fmaxf(mx, v); }
    mx = fmaxf(mx, __shfl_xor(mx, 32));
    const float mnew = fmaxf(st.m, mx), alpha = __builtin_amdgcn_exp2f(st.m - mnew); st.m = mnew;
    float ps = 0.f;
#pragma unroll
    for (int r = 0; r < 16; ++r) { t[r] = __builtin_amdgcn_exp2f(t[r] - mnew); ps += t[r]; }
    st.l = st.l * alpha + ps;
#pragma unroll
    for (int db = 0; db < 4; ++db) st.o[db] = st.o[db] * alpha;
    bf16x8 pf[2];
#pragma unroll
    for (int s2 = 0; s2 < 2; ++s2) { u32x4 w; w.x = pk2(t[8 * s2 + 0], t[8 * s2 + 1]); w.y = pk2(t[8 * s2 + 2], t[8 * s2 + 3]); w.z = pk2(t[8 * s2 + 4], t[8 * s2 + 5]); w.w = pk2(t[8 * s2 + 6], t[8 * s2 + 7]); pf[s2] = __builtin_bit_cast(bf16x8, w); }
#pragma unroll
    for (int db = 0; db < 4; ++db)
#pragma unroll
        for (int s2 = 0; s2 < 2; ++s2) st.o[db] = __builtin_amdgcn_mfma_f32_32x32x16_bf16(vf[db][s2], pf[s2], st.o[db], 0, 0, 0);
}
__device__ __forceinline__ void attn_init(AttnSt& st) {
#pragma unroll
    for (int db = 0; db < 4; ++db)
#pragma unroll
        for (int r = 0; r < 16; ++r) st.o[db][r] = 0.f;
    st.m = -1e30f; st.l = 0.f;
}
__device__ __forceinline__ void attn_finish(AttnSt& st, bf16_t* orow, int hi, float sinkl2) {
    float l = st.l + __shfl_xor(st.l, 32);
    l += __builtin_amdgcn_exp2f(sinkl2 - st.m);
    const float inv = 1.f / l;
#pragma unroll
    for (int db = 0; db < 4; ++db)
#pragma unroll
        for (int rg = 0; rg < 4; ++rg) { u32x2 w; w.x = pk2(st.o[db][4 * rg] * inv, st.o[db][4 * rg + 1] * inv); w.y = pk2(st.o[db][4 * rg + 2] * inv, st.o[db][4 * rg + 3] * inv);
            *(u32x2*)(orow + db * 32 + 8 * rg + 4 * hi) = w; }
}
__device__ __forceinline__ void load_q(bf16x8 (&qf)[8], const bf16_t* __restrict__ qp) {
#pragma unroll
    for (int d0 = 0; d0 < 8; ++d0) qf[d0] = *(const bf16x8*)(qp + 16 * d0);
}
struct AttnArgs { const bf16_t *QKV, *VT, *cKa, *cVta, *cKb, *cVtb; bf16_t* AO; const float *sink, *rpb; };
__device__ __forceinline__ void attn_prompt_unit(const AttnArgs& A, int pu, int lane) {
    const int r32 = lane & 31, hi = lane >> 5, qb = pu & 7, h16 = (pu >> 3) & 15, b = pu >> 7;
    const bool isb = h16 >= 8; const int hq = h16 - 8;
    const int qcol = isb ? 3072 + hq * 128 : h16 * 128, kcol = isb ? 4096 + (hq >> 2) * 128 : 1024 + h16 * 128, vrow = isb ? 1024 + (hq >> 2) * 128 : h16 * 128, ocol = isb ? 1024 + hq * 128 : h16 * 128;
    const int row = b * 256 + qb * 32 + r32;
    bf16x8 qf[8]; load_q(qf, A.QKV + (size_t)row * NQKV + qcol + 8 * hi);
    AttnSt st; attn_init(st);
    const bf16_t* kp = A.QKV + (size_t)(b * 256 + pi32(r32)) * NQKV + kcol + 8 * hi;
    const bf16_t* vp = A.VT + (size_t)(vrow + r32) * MT + b * 256 + 8 * hi;
#pragma unroll 1
    for (int kt = 0; kt < 8; ++kt) attn_tile<0>(st, qf, kp + (size_t)kt * 32 * NQKV, vp + kt * 32, (size_t)32 * MT, hi, 0, 0, nullptr);
    attn_finish(st, A.AO + (size_t)row * DM + ocol, hi, isb ? A.sink[hq] * 1.4426950408889634f : -1e30f);
}
__device__ __forceinline__ void attn_na_unit(const AttnArgs& A, int u, int lane) {
    const int r32 = lane & 31, hi = lane >> 5, qb = u & 31, h = (u >> 5) & 7, b = u >> 8;
    const int rq = qb >> 1, jq0 = (qb & 1) * 32, tokbase = 4096 + b * 1024;
    const int row = tokbase + rq * 64 + jq0 + r32;
    bf16x8 qf[8]; load_q(qf, A.QKV + (size_t)row * NQKV + h * 128 + 8 * hi);
    AttnSt st; attn_init(st);
    { const bf16_t* kp = A.cKa + (size_t)(b * 256 + pi32(r32)) * 1024 + h * 128 + 8 * hi; const bf16_t* vp = A.cVta + (size_t)(b * 1024 + h * 128 + r32) * 256 + 8 * hi;
#pragma unroll 1
      for (int kt = 0; kt < 8; ++kt) attn_tile<0>(st, qf, kp + (size_t)kt * 32 * 1024, vp + kt * 32, (size_t)32 * 256, hi, 0, 0, nullptr); }
    const int r0 = min(max(rq - 4, 0), 8);
    const bf16_t* kp = A.QKV + (size_t)(tokbase + pi32(r32)) * NQKV + 1024 + h * 128 + 8 * hi; const bf16_t* vp = A.VT + (size_t)(h * 128 + r32) * MT + tokbase + 8 * hi;
#pragma unroll 1
    for (int i = 0; i < 16; ++i) { const int kr = r0 + (i >> 1), ch = i & 1, tok = kr * 64 + ch * 32;
        attn_tile<1>(st, qf, kp + (size_t)tok * NQKV, vp + tok, (size_t)32 * MT, hi, ch * 32, jq0 + r32, A.rpb + (h * 15 + (kr - rq + 7)) * 31); }
    attn_finish(st, A.AO + (size_t)row * DM + h * 128, hi, -1e30f);
}
__device__ __forceinline__ void attn_win_unit(const AttnArgs& A, int u, int lane) {
    const int r32 = lane & 31, hi = lane >> 5, qb = u & 31, hq = (u >> 5) & 7, b = u >> 8, kvh = hq >> 2;
    const int tokbase = 4096 + b * 1024, q0 = qb * 32, row = tokbase + q0 + r32;
    bf16x8 qf[8]; load_q(qf, A.QKV + (size_t)row * NQKV + 3072 + hq * 128 + 8 * hi);
    AttnSt st; attn_init(st);
    { const bf16_t* kp = A.cKb + (size_t)(b * 256 + pi32(r32)) * 256 + kvh * 128 + 8 * hi; const bf16_t* vp = A.cVtb + (size_t)(b * 256 + kvh * 128 + r32) * 256 + 8 * hi;
#pragma unroll 1
      for (int kt = 0; kt < 8; ++kt) attn_tile<0>(st, qf, kp + (size_t)kt * 32 * 256, vp + kt * 32, (size_t)32 * 256, hi, 0, 0, nullptr); }
    const bf16_t* kp = A.QKV + (size_t)(tokbase + pi32(r32)) * NQKV + 4096 + kvh * 128 + 8 * hi; const bf16_t* vp = A.VT + (size_t)(1024 + kvh * 128 + r32) * MT + tokbase + 8 * hi;
    const int k0 = max(qb - 4, 0), k1 = min(qb + 4, 31);
#pragma unroll 1
    for (int kt = k0; kt <= k1; ++kt) attn_tile<2>(st, qf, kp + (size_t)kt * 32 * NQKV, vp + kt * 32, (size_t)32 * MT, hi, kt * 32, q0 + r32, nullptr);
    attn_finish(st, A.AO + (size_t)row * DM + 1024 + hq * 128, hi, A.sink[hq] * 1.4426950408889634f);
}
__device__ __forceinline__ void attn_phase(const AttnArgs& A, int G, int bid, int tid) {
    const int wave = __builtin_amdgcn_readfirstlane(tid >> 6), lane = tid & 63, gw = bid * 8 + wave, NGW = G * 8;
    for (int u = gw; u < 2048; u += NGW) {
        if (u < 512) attn_na_unit(A, u, lane);
        else if (u < 1024) attn_win_unit(A, u - 512, lane);
        else { attn_prompt_unit(A, 2 * (u - 1024), lane); attn_prompt_unit(A, 2 * (u - 1024) + 1, lane); }
    }
}

struct ScanArgs { const bf16_t* XRG; float* HF; bf16_t* YR; const bf16_t* WG; const float *conv_w, *conv_b, *b_a, *b_x, *lam, *st_f, *st_b; float* out; };
__device__ __forceinline__ float gelu_tanh(float x) { const float u = 0.7978845608028654f * (x + 0.044715f * x * x * x); const float e = __expf(2.f * u); const float th = 1.f - 2.f / (e + 1.f); return 0.5f * x * (1.f + th); }
__device__ __forceinline__ void scan_unit(const ScanArgs& A, LAS unsigned char* lds, int s, int n, int tid) {
    const int wave = __builtin_amdgcn_readfirstlane(tid >> 6), lane = tid & 63, r32_ = lane & 31, hi_ = lane >> 5, r32 = r32_, hi = hi_;
    const int T = (s < 16) ? 256 : 1024, row0 = (s < 16) ? s * 256 : 4096 + (s - 16) * 1024, c0 = n * 128, NC = T / 64;
    LAS unsigned char* Abf = lds;
    LAS float* XC = (LAS float*)(lds + 17408);
    LAS float* AA = (LAS float*)(lds + 50176);
    LAS float* BB = (LAS float*)(lds + 82944);
    LAS float* SEGA = (LAS float*)(lds + 115712);
    LAS float* SEGB = SEGA + 512;
    LAS float* CAR = (LAS float*)(lds + 119808);
    const int cq_ = tid & 31, tg_ = tid >> 5, cq = cq_, tg = tg_;
    const int cb = wave & 3, rt = wave >> 2;
    const int sc_c_ = tid & 127, sg_ = tid >> 7;
    f32x4 cw[4];
#pragma unroll
    for (int k = 0; k < 4; ++k) cw[k] = *(const f32x4*)(A.conv_w + k * 2048 + c0 + 4 * cq);
    const f32x4 cbv = *(const f32x4*)(A.conv_b + c0 + 4 * cq);
    const bf16_t* xbase0 = A.XRG + (size_t)row0 * NREC + c0;
#pragma unroll 1
    for (int dir = 0; dir < 2; ++dir) {
        const bf16_t* wgp0 = A.WG + ((size_t)((dir * 2 + 0) * 16 + n) * 128 + 32 * cb) * 128;
        const int jc = dir * 2048 + c0 + 32 * cb + r32;
        const float ba = A.b_a[jc], bx = A.b_x[jc], sp = log1pf(__expf(-A.lam[jc]));
        __syncthreads();
        if (tid < 128) { float cv = 0.f; if (s >= 16) { const float vf = A.st_f[(s - 16) * 2048 + c0 + tid], vb = A.st_b[(s - 16) * 2048 + c0 + tid]; cv = dir ? vb : vf; } CAR[tid] = cv; }
        u32x2 xraw[7];
        { const bf16_t* xbase = xbase0 + 4 * cq; const int cc = dir ? NC - 1 : 0, tb = cc * 64 + 4 * tg - 2;
#pragma unroll
          for (int i = 0; i < 7; ++i) { const int t = tb + i; xraw[i] = (t >= 0 && t < T) ? *(const u32x2*)(xbase + (size_t)t * NREC) : (u32x2){0u, 0u}; } }
#pragma unroll 1
        for (int ci = 0; ci < NC; ++ci) {
            const int cc = dir ? NC - 1 - ci : ci, t0 = cc * 64;
            int cq = cq_, tg = tg_, r32 = r32_, hi = hi_, sc_c = sc_c_, sg = sg_;
            asm volatile("" : "+v"(cq), "+v"(tg), "+v"(r32), "+v"(hi), "+v"(sc_c), "+v"(sg));
            {
                f32x4 xf[7];
#pragma unroll
                for (int i = 0; i < 7; ++i) xf[i] = (f32x4){bf2f((unsigned short)(xraw[i].x & 0xffffu)), bf2f((unsigned short)(xraw[i].x >> 16)), bf2f((unsigned short)(xraw[i].y & 0xffffu)), bf2f((unsigned short)(xraw[i].y >> 16))};
#pragma unroll
                for (int tt = 0; tt < 4; ++tt) { f32x4 v = cbv;
#pragma unroll
                    for (int k = 0; k < 4; ++k) v += cw[k] * xf[tt + k];
                    const int t = 4 * tg + tt;
                    *(LAS f32x4*)(XC + t * 128 + 4 * cq) = v;
                    u32x2 w; w.x = pk2(v[0], v[1]); w.y = pk2(v[2], v[3]); *(LAS u32x2*)(Abf + t * 272 + 8 * cq) = w; }
            }
            if (ci + 1 < NC) { const bf16_t* xbase = xbase0 + 4 * cq; const int cn = dir ? NC - 2 - ci : ci + 1, tb = cn * 64 + 4 * tg - 2;
#pragma unroll
                for (int i = 0; i < 7; ++i) { const int t = tb + i; xraw[i] = (t >= 0 && t < T) ? *(const u32x2*)(xbase + (size_t)t * NREC) : (u32x2){0u, 0u}; } }
            f32x4 hf4[4]; u32x2 g4[4];
            if (dir) {
#pragma unroll
                for (int tt = 0; tt < 4; ++tt) { const size_t r = (size_t)(row0 + t0 + 4 * tg + tt); hf4[tt] = *(const f32x4*)(A.HF + r * DM + c0 + 4 * cq); g4[tt] = *(const u32x2*)(A.XRG + r * NREC + 2048 + c0 + 4 * cq); }
            }
            bf16x8 wa[8], wx[8]; const bf16_t* wgp = wgp0 + r32 * 128 + 8 * hi;
#pragma unroll
            for (int ks = 0; ks < 8; ++ks) { wa[ks] = *(const bf16x8*)(wgp + 16 * ks); wx[ks] = *(const bf16x8*)(wgp + (size_t)16 * 16384 + 16 * ks); }
            __syncthreads();
            {
                f32x16 ga = {0.f, 0.f, 0.f, 0.f, 0.f, 0.f, 0.f, 0.f, 0.f, 0.f, 0.f, 0.f, 0.f, 0.f, 0.f, 0.f}, gx = ga;
#pragma unroll
                for (int ks = 0; ks < 8; ++ks) { const bf16x8 af = *(const LAS bf16x8*)(Abf + (32 * rt + r32) * 272 + (16 * ks + 8 * hi) * 2);
                    ga = __builtin_amdgcn_mfma_f32_32x32x16_bf16(af, wa[ks], ga, 0, 0, 0); gx = __builtin_amdgcn_mfma_f32_32x32x16_bf16(af, wx[ks], gx, 0, 0, 0); }
#pragma unroll
                for (int r = 0; r < 16; ++r) { const int t = 32 * rt + (r & 3) + 8 * (r >> 2) + 4 * hi, j = 32 * cb + r32;
                    const float rr = 1.f / (1.f + __expf(-(ga[r] + ba))), ii = 1.f / (1.f + __expf(-(gx[r] + bx)));
                    const float la = -8.f * rr * sp, a = __expf(la), mult = sqrtf(-expm1f(2.f * la));
                    AA[t * 128 + j] = a; BB[t * 128 + j] = mult * ii * XC[t * 128 + j]; }
            }
            __syncthreads();
            {
                float av[16], bv[16]; float Aacc = 1.f, Bacc = 0.f;
#pragma unroll
                for (int k = 0; k < 16; ++k) { const int uu = 16 * sg + k, t = dir ? 63 - uu : uu; av[k] = AA[t * 128 + sc_c]; bv[k] = BB[t * 128 + sc_c]; Bacc = av[k] * Bacc + bv[k]; Aacc *= av[k]; }
                SEGA[sg * 128 + sc_c] = Aacc; SEGB[sg * 128 + sc_c] = Bacc;
                __syncthreads();
                float h = CAR[(ci & 1) * 128 + sc_c];
                for (int s2 = 0; s2 < sg; ++s2) h = SEGA[s2 * 128 + sc_c] * h + SEGB[s2 * 128 + sc_c];
#pragma unroll
                for (int k = 0; k < 16; ++k) { const int uu = 16 * sg + k, t = dir ? 63 - uu : uu; h = av[k] * h + bv[k]; BB[t * 128 + sc_c] = h; }
                if (sg == 3) { CAR[((ci + 1) & 1) * 128 + sc_c] = h;
                    if (ci == NC - 1 && s < 16) A.out[(dir ? OUT_RB : OUT_RF) + s * 2048 + c0 + sc_c] = h; }
            }
            __syncthreads();
#pragma unroll
            for (int tt = 0; tt < 4; ++tt) { const int t = 4 * tg + tt; const size_t r = (size_t)(row0 + t0 + t); const f32x4 hv = *(const LAS f32x4*)(BB + t * 128 + 4 * cq);
                if (!dir) *(f32x4*)(A.HF + r * DM + c0 + 4 * cq) = hv;
                else { const f32x4 sum = hv + hf4[tt];
                    const float g0 = gelu_tanh(bf2f((unsigned short)(g4[tt].x & 0xffffu))), g1 = gelu_tanh(bf2f((unsigned short)(g4[tt].x >> 16))), g2 = gelu_tanh(bf2f((unsigned short)(g4[tt].y & 0xffffu))), g3 = gelu_tanh(bf2f((unsigned short)(g4[tt].y >> 16)));
                    u32x2 w; w.x = pk2(sum[0] * g0, sum[1] * g1); w.y = pk2(sum[2] * g2, sum[3] * g3); *(u32x2*)(A.YR + r * DM + c0 + 4 * cq) = w; } }
        }
    }
    __syncthreads();
}
__device__ __forceinline__ void scan_phase(const ScanArgs& A, LAS unsigned char* lds, int G, int bid, int tid) {
#pragma unroll 1
    for (int i = 0;; ++i) {
        int u;
        if (G == 256) { if (i == 0) u = bid; else if (i == 1 && bid >= 32 && bid < 64) u = 256 + bid - 32; else break; }
        else { u = bid + i * G; if (u >= 288) break; }
        const int s = (u < 32) ? 16 + (u >> 4) : (u - 32) >> 4, n = (u < 32) ? (u & 15) : ((u - 32) & 15);
        scan_unit(A, lds, s, n, tid);
    }
}

#define XB_TMO      128
#define XB_XCNT(j)  (256  + 64 * (j))
#define XB_XSUB(j)  (1280 + 64 * (j))
#define XB_XGEN(j)  (2304 + 64 * (j))
#define XB_TOP      3328
#define XB_TOPGEN   3392
#define XCD_BAR_WORDS 3456
#define XB_SPIN_CAP (1u << 18)

__device__ __forceinline__ unsigned xb_ld(unsigned* p)              { return __hip_atomic_load(p, __ATOMIC_RELAXED, __HIP_MEMORY_SCOPE_AGENT); }
__device__ __forceinline__ unsigned xb_add(unsigned* p, unsigned v) { return __hip_atomic_fetch_add(p, v, __ATOMIC_RELAXED, __HIP_MEMORY_SCOPE_AGENT); }
__device__ __forceinline__ unsigned xb_xcc_id() { return (unsigned)__builtin_amdgcn_s_getreg((3 << 11) | 20) & 0xFu; }
#define XB_SPIN(cond, bar) do { unsigned _sp = 0; while (cond) { __builtin_amdgcn_s_sleep(1); \
    if ((++_sp & 255u) == 0u) { if (xb_ld(&(bar)[XB_TMO])) break; if (_sp > XB_SPIN_CAP) { atomicAdd(&(bar)[XB_TMO], 1u); break; } } } } while (0)

struct XcdBarrier {
    unsigned* bar; unsigned x;
    volatile LAS unsigned* st;
};

__device__ __forceinline__ XcdBarrier xcd_barrier_post(unsigned* bar, volatile LAS unsigned* st) {
    XcdBarrier b; b.bar = bar; b.x = xb_xcc_id(); b.st = st;
    if (threadIdx.x == 0) (void)xb_add(&bar[XB_XCNT(b.x)], 1u);
    return b;
}
__device__ __forceinline__ void xcd_barrier_complete(unsigned* bar, unsigned x, unsigned& nloc, unsigned& nx) {
    const unsigned G = gridDim.x * gridDim.y * gridDim.z;
    unsigned sum, cnt, mine, sp = 0u;
    for (;;) {
        sum = 0u; cnt = 0u; mine = 0u;
#pragma unroll
        for (unsigned j = 0; j < 16; ++j) { const unsigned c = xb_ld(&bar[XB_XCNT(j)]); sum += c; cnt += (c > 0u) ? 1u : 0u; mine = (j == x) ? c : mine; }
        if (sum == G) break;
        __builtin_amdgcn_s_sleep(1);
        if ((++sp & 255u) == 0u) { if (xb_ld(&bar[XB_TMO])) break; if (sp > XB_SPIN_CAP) { atomicAdd(&bar[XB_TMO], 1u); break; } }
    }
    nloc = mine > 0u ? mine : 1u; nx = cnt > 0u ? cnt : 1u;
}

__device__ __forceinline__ void xcd_barrier(const XcdBarrier& b) {
    asm volatile("s_waitcnt vmcnt(0)" ::: "memory");
    __syncthreads();
    if (threadIdx.x == 0) {
        unsigned* bar = b.bar;
        __builtin_amdgcn_s_waitcnt(0);
        unsigned nloc = b.st[0], nx = b.st[1];
        if (nloc == 0u) { xcd_barrier_complete(bar, b.x, nloc, nx); b.st[0] = nloc; b.st[1] = nx; }
        const unsigned old = xb_add(&bar[XB_XSUB(b.x)], 1u);
        const unsigned gen = old / nloc;
        if (old + 1u == (gen + 1u) * nloc) {
            __builtin_amdgcn_fence(__ATOMIC_RELEASE, "agent");
            asm volatile("s_waitcnt vmcnt(0)" ::: "memory");
            const unsigned og = xb_add(&bar[XB_TOP], 1u);
            const unsigned tg = og / nx;
            if (og + 1u == (tg + 1u) * nx) xb_add(&bar[XB_TOPGEN], 1u);
            else XB_SPIN(xb_ld(&bar[XB_TOPGEN]) == tg, bar);
            __builtin_amdgcn_fence(__ATOMIC_ACQUIRE, "agent");
            xb_add(&bar[XB_XGEN(b.x)], 1u);
            asm volatile("s_waitcnt vmcnt(0)" ::: "memory");
        } else {
            XB_SPIN(xb_ld(&bar[XB_XGEN(b.x)]) == gen, bar);
            __builtin_amdgcn_fence(__ATOMIC_ACQUIRE, "agent");
            asm volatile("s_waitcnt vmcnt(0)" ::: "memory");
        }
    }
    __syncthreads();
}

struct Params { const float* in[31]; float* out; unsigned char* ws; int ph_lo, ph_hi; };
__global__ void __launch_bounds__(512, 2) mega_fwd(Params P) {
    extern __shared__ __attribute__((aligned(16))) unsigned char lds_raw[];
    LAS unsigned char* lds = (LAS unsigned char*)lds_raw;
    const int tid = threadIdx.x, G = gridDim.x, bid = blockIdx.x;
    const int wave = __builtin_amdgcn_readfirstlane(tid >> 6), lane = tid & 63;
    unsigned char* ws = P.ws;
    const int lo = P.ph_lo, hi = P.ph_hi;
    bf16_t* XN = (bf16_t*)(ws + WS_XN); bf16_t* QKV = (bf16_t*)(ws + WS_QKV); bf16_t* VT = (bf16_t*)(ws + WS_VT); bf16_t* AO = (bf16_t*)(ws + WS_AO);
    float* O32 = (float*)(ws + WS_O32); float* Y = (float*)(ws + WS_Y); bf16_t* H = (bf16_t*)(ws + WS_H); bf16_t* XRG = (bf16_t*)(ws + WS_XRG); float* HF = (float*)(ws + WS_HF);
    const float* mod = (const float*)(ws + WS_MOD);
    const float *g_pre_mix = P.in[12], *g_post_mix = P.in[13], *g_pre_ffn = P.in[14], *g_post_ffn = P.in[15];
    volatile LAS unsigned* bst = (volatile LAS unsigned*)(lds + 131072 + 64);
    if (tid < 2) bst[tid] = 0u;
    __syncthreads();
    if (hi - lo > 1) (void)xcd_barrier_post((unsigned*)(ws + WS_BAR), bst);
    if (lo == -12345) cg::this_grid().sync();
#ifndef PH_MASK
#define PH_MASK 0xFFFF
#endif
#define IN(k) ((((PH_MASK) >> (k)) & 1) && lo <= (k) && (k) < hi)
#define SEAM(k) do { if (IN(k) && IN((k) + 1)) { XcdBarrier bar_; bar_.bar = (unsigned*)(P.ws + WS_BAR); bar_.x = xb_xcc_id(); bar_.st = (volatile LAS unsigned*)(lds + 131072 + 64); xcd_barrier(bar_); } } while (0)
#define MODP(l, ci, ch) (mod + ((size_t)((l) * 3 + (ci)) * 6 + (ch)) * 2048)
    if (IN(0)) for (int rep_ = 0; rep_ < 1 + (((REP_MASK) >> 0) & 1); ++rep_) {
        P0Args A{P.in[16], P.in[17], P.in[20], P.in[28], P.in[29], P.in[30], P.in[23], P.in[25], P.in[10], P.in[11], P.in[9], P.in[2], P.in[3], P.in[4], P.in[5], P.in[6], ws};
        p0_prologue(A, lds, G, bid, tid);
    }
    SEAM(0);
    if (IN(1)) for (int rep_ = 0; rep_ < 1 + (((REP_MASK) >> 1) & 1); ++rep_) {
_Pragma("unroll 1")
        for (int m = bid * 8 + wave; m < MT; m += G * 8) { const int ci = (m < 4096) ? 0 : 1 + ((m - 4096) >> 10);
            const float* x = (m < 4096) ? P.in[0] + (size_t)m * DM : P.in[1] + (size_t)(m - 4096) * DM;
            norm_row(x, nullptr, nullptr, nullptr, nullptr, g_pre_mix, MODP(0, ci, 1), MODP(0, ci, 0), XN + (size_t)m * DM, lane); }
    }
    SEAM(1);
    if (IN(2)) { constexpr int REPK = 1 + (((REP_MASK) >> 2) & 1);
        pg8::Gemm g{XN, (const bf16_t*)(ws + WS_WQKV), MT, NQKV, DM}; pg8::StaticOrder S; S.init(MT, NQKV, G, bid); S.rep = REPK;
        pg8::EpiQKV E{QKV, VT, P.out, (const float*)(ws + WS_ROPE)};
        pg8::gemm_phase<pg8::EpiQKV, pg8::StaticOrder, true, true>(lds, g, S, E);
    }
    SEAM(2);
    if (IN(3)) for (int rep_ = 0; rep_ < 1 + (((REP_MASK) >> 3) & 1); ++rep_) {
        AttnArgs A{QKV, VT, (const bf16_t*)(ws + WS_CKA), (const bf16_t*)(ws + WS_CVTA), (const bf16_t*)(ws + WS_CKB), (const bf16_t*)(ws + WS_CVTB), AO, P.in[18], P.in[19]};
        attn_phase(A, G, bid, tid);
    }
    SEAM(3);
    if (IN(4)) { constexpr int REPK = 1 + (((REP_MASK) >> 4) & 1);
        pg8::Gemm g{AO, (const bf16_t*)(ws + WS_WO), MT, DM, DM}; pg8::StaticOrder S; S.init(MT, DM, G, bid); S.rep = REPK;
        pg8::EpiF32 E{O32, DM};
        pg8::gemm_phase<pg8::EpiF32, pg8::StaticOrder, true, true>(lds, g, S, E);
    }
    SEAM(4);
    if (IN(5)) for (int rep_ = 0; rep_ < 1 + (((REP_MASK) >> 5) & 1); ++rep_) {
_Pragma("unroll 1")
        for (int m = bid * 8 + wave; m < MT; m += G * 8) { const int ci = (m < 4096) ? 0 : 1 + ((m - 4096) >> 10);
            const float* x = (m < 4096) ? P.in[0] + (size_t)m * DM : P.in[1] + (size_t)(m - 4096) * DM;
            norm_row(x, O32 + (size_t)m * DM, MODP(0, ci, 2), g_post_mix, Y + (size_t)m * DM, g_pre_ffn, MODP(0, ci, 4), MODP(0, ci, 3), XN + (size_t)m * DM, lane); }
    }
    SEAM(5);
    if (IN(6)) { constexpr int REPK = 1 + (((REP_MASK) >> 6) & 1);
        pg8::Gemm g{XN, (const bf16_t*)(ws + WS_W1), MT, DFF, DM}; pg8::StaticOrder S; S.init(MT, DFF, G, bid); S.rep = REPK;
        pg8::EpiBf16<2> E{H, DFF};
        pg8::gemm_phase<pg8::EpiBf16<2>, pg8::StaticOrder, true, true>(lds, g, S, E);
    }
    SEAM(6);
    if (IN(7)) { constexpr int REPK = 1 + (((REP_MASK) >> 7) & 1);
        pg8::Gemm g{H, (const bf16_t*)(ws + WS_W2), MT, DM, DFF}; pg8::StaticOrder S; S.init(MT, DM, G, bid); S.rep = REPK;
        pg8::EpiF32 E{O32, DM};
        pg8::gemm_phase<pg8::EpiF32, pg8::StaticOrder, true, true>(lds, g, S, E);
    }
    SEAM(7);
    if (IN(8)) for (int rep_ = 0; rep_ < 1 + (((REP_MASK) >> 8) & 1); ++rep_) {
_Pragma("unroll 1")
        for (int m = bid * 8 + wave; m < MT; m += G * 8) { const int ci = (m < 4096) ? 0 : 1 + ((m - 4096) >> 10);
            norm_row(Y + (size_t)m * DM, O32 + (size_t)m * DM, MODP(0, ci, 5), g_post_ffn, Y + (size_t)m * DM, g_pre_mix + DM, MODP(1, ci, 1), MODP(1, ci, 0), XN + (size_t)m * DM, lane); }
    }
    SEAM(8);
    if (IN(9)) { constexpr int REPK = 1 + (((REP_MASK) >> 9) & 1);
        pg8::Gemm g{XN, (const bf16_t*)(ws + WS_WRIN), MT, NREC, DM}; pg8::StaticOrder S; S.init(MT, NREC, G, bid); S.rep = REPK;
        pg8::EpiBf16<0> E{XRG, NREC};
        pg8::gemm_phase<pg8::EpiBf16<0>, pg8::StaticOrder, true, true>(lds, g, S, E);
    }
    SEAM(9);
    if (IN(10)) for (int rep_ = 0; rep_ < 1 + (((REP_MASK) >> 10) & 1); ++rep_) {
        ScanArgs A{XRG, HF, AO, (const bf16_t*)(ws + WS_WG), P.in[21], P.in[22], P.in[24], P.in[26], P.in[27], P.in[7], P.in[8], P.out};
        scan_phase(A, lds, G, bid, tid);
    }
    SEAM(10);
    if (IN(11)) { constexpr int REPK = 1 + (((REP_MASK) >> 11) & 1);
        pg8::Gemm g{AO, (const bf16_t*)(ws + WS_WROUT), MT, DM, DM}; pg8::StaticOrder S; S.init(MT, DM, G, bid); S.rep = REPK;
        pg8::EpiF32 E{O32, DM};
        pg8::gemm_phase<pg8::EpiF32, pg8::StaticOrder, true, true>(lds, g, S, E);
    }
    SEAM(11);
    if (IN(12)) for (int rep_ = 0; rep_ < 1 + (((REP_MASK) >> 12) & 1); ++rep_) {
_Pragma("unroll 1")
        for (int m = bid * 8 + wave; m < MT; m += G * 8) { const int ci = (m < 4096) ? 0 : 1 + ((m - 4096) >> 10);
            norm_row(Y + (size_t)m * DM, O32 + (size_t)m * DM, MODP(1, ci, 2), g_post_mix + DM, Y + (size_t)m * DM, g_pre_ffn + DM, MODP(1, ci, 4), MODP(1, ci, 3), XN + (size_t)m * DM, lane); }
    }
    SEAM(12);
    if (IN(13)) { constexpr int REPK = 1 + (((REP_MASK) >> 13) & 1);
        pg8::Gemm g{XN, (const bf16_t*)(ws + WS_W1) + (size_t)DM * DFF, MT, DFF, DM}; pg8::StaticOrder S; S.init(MT, DFF, G, bid); S.rep = REPK;
        pg8::EpiBf16<2> E{H, DFF};
        pg8::gemm_phase<pg8::EpiBf16<2>, pg8::StaticOrder, true, true>(lds, g, S, E);
    }
    SEAM(13);
    if (IN(14)) { constexpr int REPK = 1 + (((REP_MASK) >> 14) & 1);
        pg8::Gemm g{H, (const bf16_t*)(ws + WS_W2) + (size_t)DM * DFF, MT, DM, DFF}; pg8::StaticOrder S; S.init(MT, DM, G, bid); S.rep = REPK;
        pg8::EpiF32 E{O32, DM};
        pg8::gemm_phase<pg8::EpiF32, pg8::StaticOrder, true, true>(lds, g, S, E);
    }
    SEAM(14);
    if (IN(15)) for (int rep_ = 0; rep_ < 1 + (((REP_MASK) >> 15) & 1); ++rep_) {
_Pragma("unroll 1")
        for (int m = bid * 8 + wave; m < MT; m += G * 8) { const int ci = (m < 4096) ? 0 : 1 + ((m - 4096) >> 10);
            norm_row(Y + (size_t)m * DM, O32 + (size_t)m * DM, MODP(1, ci, 5), g_post_ffn + DM, P.out + (size_t)m * DM, nullptr, nullptr, nullptr, nullptr, lane); }
    }
#undef IN
#undef SEAM
#undef MODP
}

#ifndef MK_MULTI
#define MK_MULTI 0
#endif
extern "C" void kernel_launch(void* const* d_in, const int* in_sizes, int n_in, void* d_out, int out_size, void* d_ws, size_t ws_size, hipStream_t stream) {
    static int grid = 0;
    if (grid == 0) {
        if (n_in != 31 || ws_size < WS_END) { fprintf(stderr, "kernel_launch: unexpected n_in %d / ws %zu\n", n_in, ws_size); grid = -1; return; }
        int dev = 0, cus = 0, per_cu = 0;
        (void)hipGetDevice(&dev); (void)hipDeviceGetAttribute(&cus, hipDeviceAttributeMultiprocessorCount, dev);
        (void)hipFuncSetAttribute((const void*)mega_fwd, hipFuncAttributeMaxDynamicSharedMemorySize, LDS_BYTES);
        (void)hipOccupancyMaxActiveBlocksPerMultiprocessor(&per_cu, (const void*)mega_fwd, 512, LDS_BYTES);
        if (per_cu < 1) per_cu = 1;
        grid = cus * 1;
        if (grid <= 0) grid = 256;
        (void)hipGetLastError();
    }
    if (grid < 0) return;
    (void)hipMemsetAsync((char*)d_ws + WS_MOD, 0, CTL_ZERO_BYTES, stream);
    Params p{};
    for (int i = 0; i < 31; ++i) p.in[i] = (const float*)d_in[i];
    p.out = (float*)d_out; p.ws = (unsigned char*)d_ws;
#if MK_MULTI
    for (int ph = 0; ph < NPHASE; ++ph) { p.ph_lo = ph; p.ph_hi = ph + 1; hipLaunchKernelGGL(mega_fwd, dim3(grid), dim3(512), LDS_BYTES, stream, p); }
#else
    p.ph_lo = 0; p.ph_hi = NPHASE;
    void* args[] = {&p};
    hipError_t e = hipLaunchCooperativeKernel((const void*)mega_fwd, dim3(grid), dim3(512), args, LDS_BYTES, stream);
    if (e != hipSuccess) fprintf(stderr, "cooperative launch failed: %s (grid %d)\n", hipGetErrorString(e), grid);
#endif
}
```

```cpp
#include <hip/hip_runtime.h>
#include <hip/hip_cooperative_groups.h>
#include <cstdio>
#include <cstdint>
namespace cg = cooperative_groups;

constexpr int OUT_YP = 0, OUT_YS = 8388608, OUT_AK = 12582912, OUT_AV = 16777216, OUT_BK = 20971520, OUT_BV = 22020096, OUT_RF = 23068672, OUT_RB = 23101440;
typedef float f32x2_t __attribute__((ext_vector_type(2)));
typedef __bf16 bf16x2_t __attribute__((ext_vector_type(2)));
__device__ __forceinline__ unsigned pk2(float lo, float hi) { f32x2_t v = {lo, hi}; bf16x2_t b = __builtin_convertvector(v, bf16x2_t); return __builtin_bit_cast(unsigned, b); }
__device__ __forceinline__ float bf2f(unsigned short h) { return __builtin_bit_cast(float, (unsigned)h << 16); }
namespace pg8 {
#define PG8_LAS __attribute__((address_space(3)))
typedef unsigned short bf16_t;
typedef short bf16x8 __attribute__((ext_vector_type(8)));
typedef float f32x4 __attribute__((ext_vector_type(4)));
typedef unsigned u32x4 __attribute__((ext_vector_type(4)));
constexpr int BM = 256, BK = 64, HALF = 128, HTB = HALF * BK * 2  , STAGE_BYTES = 8 * HTB, NXCD = 8, WGM = 8;

__host__ __device__ __forceinline__ int lds_byte(int r, int c) { const int st = (r >> 4) * 2 + (c >> 5), rr = r & 15, cc = c & 31, ob = rr * 64 + cc * 2; return st * 1024 + (ob ^ (((ob >> 9) & 1) << 5)); }
__host__ __device__ __forceinline__ void stage_rc(int b, int& R, int& C) { const int st = b / 1024, sb = b % 1024, swz = sb ^ (((sb >> 9) & 1) << 5); R = (st >> 1) * 16 + swz / 64; C = (st & 1) * 32 + (swz % 64) / 2; }
__host__ __device__ __forceinline__ int perm32(int rho) { const int n = rho >> 4, i = rho & 15; return 8 * (i >> 2) + 4 * n + (i & 3); }

struct Unit { int pm, pn; };
struct Gemm { const bf16_t* A; const bf16_t* Bt; int M, N, K; };

struct StaticOrder {
    int nM, nN, nwg, G, c, rep;
    __host__ __device__ void init(int M, int N, int G_, int c_, int bm = BM) { nM = M / bm; nN = N / BM; nwg = nM * nN; G = G_; c = c_; rep = 1; }
    __host__ __device__ bool next(int i, Unit& u) const {
        long L = (long)i * G + c; if (L >= (long)nwg * rep) return false; L %= nwg;
        int wgid = (int)L; { const int q = nwg / NXCD, r = nwg % NXCD, xcd = wgid % NXCD, off = wgid / NXCD; wgid = (xcd < r ? xcd * (q + 1) : r * (q + 1) + (xcd - r) * q) + off; }
        const int nig = WGM * nN, gid = wgid / nig, fm = gid * WGM, gsz = (nM - fm) < WGM ? (nM - fm) : WGM;
        u.pm = fm + ((wgid % nig) % gsz); u.pn = (wgid % nig) / gsz; return true;
    }
    __device__ __forceinline__ void a_ready(const Unit&) const {}
    __device__ __forceinline__ void done(const Unit&) const {}
};

template <int MB> struct EpiF32 {
    static constexpr bool PERM = false, AFTER_DRAIN = false;
    float* O; int ldc;
    __device__ __forceinline__ void operator()(const f32x4 (&acc)[2][2][4][2], const Unit& u, int wr, int wc, int fr, int fq) const {
        const int row0 = u.pm * (64 * MB) + wr * (16 * MB) + fr, col0 = u.pn * BM + wc * 32 + 4 * fq;
#pragma unroll
        for (int ai = 0; ai < 2; ++ai)
#pragma unroll
            for (int m = 0; m < MB; ++m) { float* rowp = O + (size_t)(row0 + ai * (32 * MB) + m * 16) * ldc + col0;
#pragma unroll
                for (int bj = 0; bj < 2; ++bj)
#pragma unroll
                    for (int n = 0; n < 2; ++n) *(f32x4*)(rowp + bj * HALF + n * 16) = acc[ai][bj][m][n]; }
    }
};
template <int ACT  , int MB> struct EpiBf16 {
    static constexpr bool PERM = true, AFTER_DRAIN = false;
    bf16_t* O; int ldc;
    __device__ __forceinline__ void operator()(const f32x4 (&acc)[2][2][4][2], const Unit& u, int wr, int wc, int fr, int fq) const {
        const int row0 = u.pm * (64 * MB) + wr * (16 * MB) + fr, col0 = u.pn * BM + wc * 32 + 8 * fq;
#pragma unroll
        for (int ai = 0; ai < 2; ++ai)
#pragma unroll
            for (int m = 0; m < MB; ++m) { bf16_t* rowp = O + (size_t)(row0 + ai * (32 * MB) + m * 16) * ldc + col0;
#pragma unroll
                for (int bj = 0; bj < 2; ++bj) { f32x4 v0 = acc[ai][bj][m][0], v1 = acc[ai][bj][m][1];
                    if (ACT == 2) {
#pragma unroll
                        for (int i = 0; i < 4; ++i) { const float a = fmaxf(v0[i], 0.f), b = fmaxf(v1[i], 0.f); v0[i] = a * a; v1[i] = b * b; } }
                    u32x4 w; w.x = pk2(v0[0], v0[1]); w.y = pk2(v0[2], v0[3]); w.z = pk2(v1[0], v1[1]); w.w = pk2(v1[2], v1[3]);
                    *(u32x4*)(rowp + bj * HALF) = w; } }
    }
};
struct EpiQKV {
    static constexpr bool PERM = true, AFTER_DRAIN = false;
    bf16_t* QKV; bf16_t* KF; bf16_t* VF; float* out; const float* rope;
    __device__ __forceinline__ void operator()(const f32x4 (&acc)[2][2][4][2], const Unit& u, int wr, int wc, int fr, int fq) const {
        const int pn = u.pn, pm = u.pm; const bool prompt = pm < 16;
        const int row0 = pm * BM + wr * 64 + fr, colp = wc * 32 + 8 * fq;
        if ((pn >= 8 && pn < 12) || pn == 17) {
            const bool isb = (pn == 17);
            const int vhead0 = isb ? 8 : (pn - 8) * 2;
            float* of = out + (isb ? OUT_BV : OUT_AV); const int ldo = isb ? 256 : 1024, ocol0 = isb ? 0 : (pn - 8) * 256;
#pragma unroll
            for (int ai = 0; ai < 2; ++ai)
#pragma unroll
                for (int m = 0; m < 4; ++m) { const int row = row0 + ai * HALF + m * 16;
#pragma unroll
                    for (int bj = 0; bj < 2; ++bj) { const f32x4 v0 = acc[ai][bj][m][0], v1 = acc[ai][bj][m][1]; const int c = bj * HALF + colp;
                        const int kl = row & 31;
                        bf16_t* vp = VF + ((((((size_t)(vhead0 + bj) * 192 + (row >> 5)) * 4 + wc) * 2 + (kl >> 4)) * 2 + ((kl >> 3) & 1)) * 32 + 8 * fq) * 8 + (kl & 7);
                        const unsigned w0 = pk2(v0[0], v0[1]), w1 = pk2(v0[2], v0[3]), w2 = pk2(v1[0], v1[1]), w3 = pk2(v1[2], v1[3]);
                        vp[0 * 8] = (bf16_t)(w0 & 0xffffu); vp[1 * 8] = (bf16_t)(w0 >> 16); vp[2 * 8] = (bf16_t)(w1 & 0xffffu); vp[3 * 8] = (bf16_t)(w1 >> 16);
                        vp[4 * 8] = (bf16_t)(w2 & 0xffffu); vp[5 * 8] = (bf16_t)(w2 >> 16); vp[6 * 8] = (bf16_t)(w3 & 0xffffu); vp[7 * 8] = (bf16_t)(w3 >> 16);
                        if (prompt) { float* op = of + (size_t)row * ldo + ocol0 + c; *(f32x4*)op = v0; *(f32x4*)(op + 4) = v1; } } }
        } else {
            const bool ropeT = (pn >= 12) && !prompt;
            const bool isKA = (pn >= 4 && pn < 8) && prompt, isKB = (pn == 16) && prompt;
            const int e0 = 16 * (wc & 1) + 4 * fq, dlog = 64 * (wc >> 1) + e0;
#pragma unroll
            for (int ai = 0; ai < 2; ++ai)
#pragma unroll
                for (int m = 0; m < 4; ++m) { const int row = row0 + ai * HALF + m * 16;
                    f32x4 cs = {1.f, 1.f, 1.f, 1.f}, sn = {0.f, 0.f, 0.f, 0.f};
                    if (ropeT) { const int t = (row - 4096) & 1023; const int pos = (wc >> 1) ? (t & 63) : (t >> 6);
                        const f32x4 a = *(const f32x4*)(rope + (size_t)(pos * 32 + e0) * 2), b = *(const f32x4*)(rope + (size_t)(pos * 32 + e0) * 2 + 4);
                        cs = (f32x4){a[0], a[2], b[0], b[2]}; sn = (f32x4){a[1], a[3], b[1], b[3]}; }
#pragma unroll
                    for (int bj = 0; bj < 2; ++bj) { f32x4 v0 = acc[ai][bj][m][0], v1 = acc[ai][bj][m][1];
                        if (ropeT) { const f32x4 o0 = v0 * cs - v1 * sn, o1 = v1 * cs + v0 * sn; v0 = o0; v1 = o1; }
                        u32x4 w; w.x = pk2(v0[0], v0[1]); w.y = pk2(v0[2], v0[3]); w.z = pk2(v1[0], v1[1]); w.w = pk2(v1[2], v1[3]);
                        if (pn < 4 || (pn >= 12 && pn < 16)) *(u32x4*)(QKV + (size_t)row * 4608 + pn * BM + bj * HALF + colp) = w;
                        else { const int khead = (pn == 16) ? 8 + bj : (pn - 4) * 2 + bj, kl = row & 31, slot = (kl & ~12) | ((kl & 4) << 1) | ((kl & 8) >> 1);
                            *(u32x4*)(KF + (((((size_t)khead * 192 + (row >> 5)) * 8 + 2 * wc + (fq >> 1)) * 2 + (fq & 1)) * 32 + slot) * 8) = w; }
                        if (isKA) { float* op = out + OUT_AK + (size_t)row * 1024 + (pn - 4) * 256 + bj * HALF + colp; *(f32x4*)op = v0; *(f32x4*)(op + 4) = v1; }
                        if (isKB) { float* op = out + OUT_BK + (size_t)row * 256 + bj * HALF + dlog; *(f32x4*)op = v0; *(f32x4*)(op + 32) = v1; } } }
        }
    }
};
template <class Epi, class Sched, bool ALIGN_EPI = false, bool SP2 = false, int MB = 4  >
__device__ __forceinline__ void gemm_phase(PG8_LAS unsigned char* lds, const Gemm g, const Sched& S, const Epi& E) {
    const int tid = threadIdx.x, wid = __builtin_amdgcn_readfirstlane(tid >> 6), lane = tid & 63, wr = wid >> 2, wc = wid & 3, fr = lane & 15, fq = lane >> 4;
    const int K = g.K, nt = K / BK;
    unsigned voffA[2], voffB[2];
#pragma unroll
    for (int i = 0; i < 2; ++i) { int R, C; stage_rc(tid * 16 + i * 8192, R, C); const int Rb = Epi::PERM ? ((R & ~31) + perm32(R & 31)) : R;
        voffA[i] = (unsigned)(R * K + C) * 2u; voffB[i] = (unsigned)(Rb * K + C) * 2u; }
    const size_t kstep = (size_t)(BK * 2);
    const size_t hstep = (size_t)HALF * K * 2, hstepA = (size_t)(32 * MB) * K * 2;
    const size_t tstep = 2 * hstep, tstepA = 2 * hstepA;
    const unsigned ldsw = (unsigned)wid * 1024u;
    const int aoff = lds_byte(wr * (16 * MB) + fr, fq * 8), boff = lds_byte(wc * 32 + fr, fq * 8);
#define PG8_SA(b, h) (((b) * 2 + (h)) * HTB)
#define PG8_SB(b, h) ((4 + (b) * 2 + (h)) * HTB)
#define PG8_STAGE(bufoff, gbase, voff) do { _Pragma("unroll") for (int _i = 0; _i < 2; ++_i) \
        __builtin_amdgcn_global_load_lds((const unsigned*)((const char*)(gbase) + (voff)[_i]), (PG8_LAS unsigned*)(lds + (bufoff) + ldsw + _i * 8192), 16, 0, 0); } while (0)
#define PG8_LDA(dst, b, h) do { _Pragma("unroll") for (int m = 0; m < MB; ++m) _Pragma("unroll") for (int k = 0; k < 2; ++k) dst[m][k] = *(const PG8_LAS bf16x8*)(lds + PG8_SA(b, h) + aoff + m * 2048 + k * 1024); } while (0)
#define PG8_LDB(dst, b, h) do { _Pragma("unroll") for (int n = 0; n < 2; ++n) _Pragma("unroll") for (int k = 0; k < 2; ++k) dst[n][k] = *(const PG8_LAS bf16x8*)(lds + PG8_SB(b, h) + boff + n * 2048 + k * 1024); } while (0)
#define PG8_MMA(ai, bj, At, Bt) do { __builtin_amdgcn_s_setprio(1); _Pragma("unroll") for (int m = 0; m < MB; ++m) _Pragma("unroll") for (int n = 0; n < 2; ++n) _Pragma("unroll") for (int k = 0; k < 2; ++k) \
        acc[ai][bj][m][n] = __builtin_amdgcn_mfma_f32_16x16x32_bf16(Bt[n][k], At[m][k], acc[ai][bj][m][n], 0, 0, 0); __builtin_amdgcn_s_setprio(0); } while (0)
#define PG8_WAIT_V(n) asm volatile("s_waitcnt vmcnt(" #n ")" ::: "memory")
#define PG8_WAIT_L(n) asm volatile("s_waitcnt lgkmcnt(" #n ")" ::: "memory")
#define PG8_BAR __builtin_amdgcn_s_barrier()
#define PG8_SCHED __builtin_amdgcn_sched_barrier(0)
    Unit cur, nxt; int ui = 0;
    if (!S.next(0, cur)) return;
    f32x4 acc[2][2][4][2];
#pragma unroll
    for (int a = 0; a < 2; ++a)
#pragma unroll
        for (int b = 0; b < 2; ++b)
#pragma unroll
            for (int m = 0; m < 4; ++m)
#pragma unroll
                for (int n = 0; n < 2; ++n) acc[a][b][m][n] = (f32x4){0.f, 0.f, 0.f, 0.f};
    bf16x8 At[4][2], B0[2][2], B1[2][2];
    const char* cA = (const char*)g.A + (size_t)cur.pm * tstepA; const char* cB = (const char*)g.Bt + (size_t)cur.pn * tstep;
    S.a_ready(cur);
    if constexpr (SP2) {
        PG8_STAGE(PG8_SB(0, 0), cB, voffB); PG8_STAGE(PG8_SB(0, 1), cB + hstep, voffB); PG8_STAGE(PG8_SA(0, 0), cA, voffA); PG8_STAGE(PG8_SA(0, 1), cA + hstepA, voffA);
        if (wr == 1) PG8_BAR;
        PG8_WAIT_V(2); PG8_BAR;
        PG8_STAGE(PG8_SB(1, 0), cB + kstep, voffB); PG8_STAGE(PG8_SA(1, 0), cA + kstep, voffA); PG8_STAGE(PG8_SB(1, 1), cB + hstep + kstep, voffB);
        PG8_WAIT_V(6); PG8_BAR;
    } else {
        PG8_STAGE(PG8_SB(0, 0), cB, voffB); PG8_STAGE(PG8_SA(0, 0), cA, voffA); PG8_STAGE(PG8_SB(0, 1), cB + hstep, voffB); PG8_STAGE(PG8_SA(0, 1), cA + hstepA, voffA);
        if (wr == 1) PG8_BAR;
        PG8_WAIT_V(4); PG8_BAR;
        PG8_STAGE(PG8_SB(1, 0), cB + kstep, voffB); PG8_STAGE(PG8_SA(1, 0), cA + kstep, voffA); PG8_STAGE(PG8_SB(1, 1), cB + hstep + kstep, voffB);
        PG8_WAIT_V(6); PG8_BAR;
    }
    for (;;) {
        const bool has_next = S.next(ui + 1, nxt);
        const char* nA = has_next ? (const char*)g.A + (size_t)nxt.pm * tstepA : cA; const char* nB = has_next ? (const char*)g.Bt + (size_t)nxt.pn * tstep : cB;
        for (int t = 0; t < nt; t += 2) {
            const bool last = (t == nt - 2);
            const char* a1 = cA + (size_t)(t + 1) * kstep;
            const char* a2 = last ? nA : cA + (size_t)(t + 2) * kstep; const char* b2 = last ? nB : cB + (size_t)(t + 2) * kstep;
            const char* a3 = a2 + kstep; const char* b3 = b2 + kstep;
            if (last && has_next) S.a_ready(nxt);
            if constexpr (SP2) {
            PG8_LDB(B0, 0, 0); PG8_LDB(B1, 0, 1); PG8_SCHED; PG8_LDA(At, 0, 0); PG8_STAGE(PG8_SA(1, 1), a1 + hstepA, voffA);
            PG8_WAIT_V(8); PG8_WAIT_L(0); PG8_BAR; PG8_MMA(0, 0, At, B0); PG8_MMA(0, 1, At, B1); PG8_BAR; PG8_SCHED;
            PG8_LDA(At, 0, 1); PG8_STAGE(PG8_SB(0, 0), b2, voffB); PG8_STAGE(PG8_SB(0, 1), b2 + hstep, voffB); PG8_STAGE(PG8_SA(0, 0), a2, voffA);
            PG8_WAIT_V(8); PG8_WAIT_L(0); PG8_BAR; PG8_MMA(1, 0, At, B0); PG8_MMA(1, 1, At, B1); PG8_BAR; PG8_SCHED;
            PG8_LDB(B0, 1, 0); PG8_LDB(B1, 1, 1); PG8_SCHED; PG8_LDA(At, 1, 0); PG8_STAGE(PG8_SA(0, 1), a2 + hstepA, voffA);
            PG8_WAIT_V(8); PG8_WAIT_L(0); PG8_BAR; PG8_MMA(0, 0, At, B0); PG8_MMA(0, 1, At, B1); PG8_BAR; PG8_SCHED;
            PG8_LDA(At, 1, 1); PG8_STAGE(PG8_SB(1, 0), b3, voffB); PG8_STAGE(PG8_SB(1, 1), b3 + hstep, voffB); PG8_STAGE(PG8_SA(1, 0), a3, voffA);
            PG8_WAIT_V(8); PG8_WAIT_L(0); PG8_BAR; PG8_MMA(1, 0, At, B0); PG8_MMA(1, 1, At, B1); PG8_BAR; PG8_SCHED;
            } else {
            PG8_LDB(B0, 0, 0); PG8_SCHED; PG8_LDA(At, 0, 0); PG8_STAGE(PG8_SA(1, 1), a1 + hstepA, voffA);
            PG8_WAIT_L(8); PG8_BAR; PG8_WAIT_L(0); PG8_MMA(0, 0, At, B0); PG8_BAR; PG8_SCHED;
            PG8_LDB(B1, 0, 1); PG8_STAGE(PG8_SB(0, 0), b2, voffB);
            PG8_BAR; PG8_WAIT_L(0); PG8_MMA(0, 1, At, B1); PG8_BAR;
            PG8_LDA(At, 0, 1); PG8_STAGE(PG8_SA(0, 0), a2, voffA);
            PG8_BAR; PG8_WAIT_L(0); PG8_MMA(1, 0, At, B0); PG8_BAR; PG8_SCHED;
            PG8_STAGE(PG8_SB(0, 1), b2 + hstep, voffB);
            PG8_WAIT_V(6); PG8_BAR; PG8_MMA(1, 1, At, B1); PG8_BAR;
            PG8_LDB(B0, 1, 0); PG8_SCHED; PG8_LDA(At, 1, 0); PG8_STAGE(PG8_SA(0, 1), a2 + hstepA, voffA);
            PG8_WAIT_L(8); PG8_BAR; PG8_WAIT_L(0); PG8_MMA(0, 0, At, B0); PG8_BAR; PG8_SCHED;
            PG8_LDB(B1, 1, 1); PG8_STAGE(PG8_SB(1, 0), b3, voffB);
            PG8_BAR; PG8_WAIT_L(0); PG8_MMA(0, 1, At, B1); PG8_BAR;
            PG8_LDA(At, 1, 1); PG8_STAGE(PG8_SA(1, 0), a3, voffA);
            PG8_BAR; PG8_WAIT_L(0); PG8_MMA(1, 0, At, B0); PG8_BAR; PG8_SCHED;
            PG8_STAGE(PG8_SB(1, 1), b3 + hstep, voffB);
            PG8_WAIT_V(6); PG8_BAR; PG8_MMA(1, 1, At, B1); PG8_BAR;
            }
        }
        if constexpr (ALIGN_EPI) { if (wr == 0) PG8_BAR; }
        if constexpr (!Epi::AFTER_DRAIN) { E(acc, cur, wr, wc, fr, fq); S.done(cur); }
        if (!has_next) break;
#pragma unroll
        for (int a = 0; a < 2; ++a)
#pragma unroll
            for (int b = 0; b < 2; ++b)
#pragma unroll
                for (int m = 0; m < 4; ++m)
#pragma unroll
                    for (int n = 0; n < 2; ++n) acc[a][b][m][n] = (f32x4){0.f, 0.f, 0.f, 0.f};
        cur = nxt; cA = nA; cB = nB; ++ui;
        if constexpr (ALIGN_EPI) { if (wr == 1) PG8_BAR; }
    }
    PG8_WAIT_V(0);
    if constexpr (!ALIGN_EPI) { if (wr == 0) PG8_BAR; }
    PG8_BAR;
    if constexpr (Epi::AFTER_DRAIN) { E.fused(acc, cur, wr, wc, fr, fq, lds, wid, lane); S.done(cur); }
#undef PG8_SA
#undef PG8_SB
#undef PG8_STAGE
#undef PG8_LDA
#undef PG8_LDB
#undef PG8_MMA
#undef PG8_WAIT_V
#undef PG8_WAIT_L
#undef PG8_BAR
#undef PG8_SCHED
}
}
#ifndef REP_MASK
#define REP_MASK 0
#endif
#define LAS __attribute__((address_space(3)))
typedef unsigned short bf16_t;
typedef short bf16x8 __attribute__((ext_vector_type(8)));
typedef float f32x4 __attribute__((ext_vector_type(4)));
typedef float f32x16 __attribute__((ext_vector_type(16)));
typedef unsigned u32x4 __attribute__((ext_vector_type(4)));
typedef unsigned u32x2 __attribute__((ext_vector_type(2)));
constexpr int DM = 2048, MT = 6144, DFF = 8192, NQKV = 4608, NREC = 4096;
constexpr size_t MiB = (size_t)1 << 20;
constexpr size_t WS_WQKV = 0, WS_WO = 18 * MiB, WS_WRIN = 26 * MiB, WS_WROUT = 42 * MiB, WS_W1 = 50 * MiB, WS_W2 = 114 * MiB, WS_WG = 178 * MiB,
                 WS_MOD = 180 * MiB, WS_ROPE = 181 * MiB, WS_CKA = 182 * MiB, WS_CVTA = 183 * MiB, WS_CKB = 184 * MiB, WS_CVTB = 184 * MiB + 512 * 1024,
                 WS_XN = 186 * MiB, WS_QKV = 210 * MiB, WS_VT = 264 * MiB, WS_AO = 280 * MiB, WS_O32 = 304 * MiB, WS_Y = 352 * MiB, WS_H = 400 * MiB,
                 WS_XRG = 400 * MiB, WS_HF = 448 * MiB, WS_KF = 496 * MiB, WS_END = 512 * MiB;
constexpr size_t MOD_BYTES = 2 * 3 * 12288 * 4;
constexpr size_t WS_BAR = WS_MOD + 512 * 1024, CTL_ZERO_BYTES = 512 * 1024 + 16384;
constexpr int LDS_BYTES = 147456;
constexpr int NPHASE = 16;

constexpr float L2E = 1.4426950408889634f, L2E_ = L2E;
__device__ __forceinline__ int sigma_rope(int p) { const int wc = p >> 5, fq = (p >> 3) & 3, n = (p >> 2) & 1, i = p & 3; return 64 * (wc >> 1) + 32 * n + 16 * (wc & 1) + 4 * fq + i; }
__device__ __forceinline__ float silu_f(float x) { return x / (1.f + __expf(-x)); }
__device__ __forceinline__ float wave_sum(float v) {
#pragma unroll
    for (int o = 1; o < 64; o <<= 1) v += __shfl_xor(v, o);
    return v;
}

template <bool ROPEPERM>
__device__ __forceinline__ void tr_item(const float* __restrict__ W, int K, int N, bf16_t* __restrict__ WT, LAS float* scr, int item, int lane) {
    const int nblk = N / 32, kb = item / nblk, nb = item % nblk, k0 = 64 * kb, n0 = 32 * nb;
    int ncol = n0 + (lane & 31);
    if (ROPEPERM) { if (ncol >= 3072 && ncol < 4352) ncol = (ncol & ~127) + sigma_rope(ncol & 127); }
    const float* src = W + (size_t)(k0 + (lane >> 5)) * N + ncol;
    float v[32];
#pragma unroll
    for (int i = 0; i < 32; ++i) v[i] = __builtin_nontemporal_load(src + (size_t)(2 * i) * N);
#pragma unroll
    for (int i = 0; i < 32; ++i) scr[(2 * i + (lane >> 5)) * 33 + (lane & 31)] = v[i];
    asm volatile("s_waitcnt lgkmcnt(0)" ::: "memory");
    const int c = lane & 7;
#pragma unroll
    for (int j = 0; j < 4; ++j) { const int n = (lane >> 3) + 8 * j; const LAS float* s = scr + (8 * c) * 33 + n;
        u32x4 o; o.x = pk2(s[0 * 33], s[1 * 33]); o.y = pk2(s[2 * 33], s[3 * 33]); o.z = pk2(s[4 * 33], s[5 * 33]); o.w = pk2(s[6 * 33], s[7 * 33]);
        *(u32x4*)(WT + (size_t)(n0 + n) * K + k0 + 8 * c) = o; }
    asm volatile("s_waitcnt lgkmcnt(0)" ::: "memory");
}
__device__ __forceinline__ void ada_item(const float* __restrict__ w_ada, const float* __restrict__ b_ada, const float* __restrict__ c_ctx, const float* __restrict__ c_s, float* mod, LAS float* scr, int item, int lane) {
    const int kq = item & 7, cc = (item >> 3) % 96, l = item / 768;
    for (int i = lane; i < 768; i += 64) { const int ci = i >> 8, k = 256 * kq + (i & 255); const float x = (ci == 0) ? c_ctx[k] : c_s[(ci - 1) * 2048 + k]; scr[i] = silu_f(x); }
    asm volatile("s_waitcnt lgkmcnt(0)" ::: "memory");
    const int half = lane >> 5, n = 128 * cc + 4 * (lane & 31);
    const float* wp = w_ada + ((size_t)l * 2048 + 256 * kq + half) * 12288 + n;
    f32x4 a0 = {0.f, 0.f, 0.f, 0.f}, a1 = a0, a2 = a0;
#pragma unroll 1
    for (int i0 = 0; i0 < 128; i0 += 16) {
        f32x4 w[16];
#pragma unroll
        for (int i = 0; i < 16; ++i) w[i] = __builtin_nontemporal_load((const f32x4*)(wp + (size_t)(2 * (i0 + i)) * 12288));
#pragma unroll
        for (int i = 0; i < 16; ++i) { const int kk = 2 * (i0 + i) + half; a0 += w[i] * scr[kk]; a1 += w[i] * scr[256 + kk]; a2 += w[i] * scr[512 + kk]; }
    }
#pragma unroll
    for (int j = 0; j < 4; ++j) { a0[j] += __shfl_xor(a0[j], 32); a1[j] += __shfl_xor(a1[j], 32); a2[j] += __shfl_xor(a2[j], 32); }
    if (half == 0) {
        f32x4 b = {0.f, 0.f, 0.f, 0.f}; if (kq == 0) b = *(const f32x4*)(b_ada + (size_t)l * 12288 + n);
        float* m0 = mod + ((size_t)l * 3) * 12288 + n;
#pragma unroll
        for (int j = 0; j < 4; ++j) { atomicAdd(m0 + j, a0[j] + b[j]); atomicAdd(m0 + 12288 + j, a1[j] + b[j]); atomicAdd(m0 + 2 * 12288 + j, a2[j] + b[j]); }
    }
    asm volatile("s_waitcnt lgkmcnt(0)" ::: "memory");
}
struct P0Args { const float *w_att_in, *w_att_out, *w_rec_in, *w_rec_out, *w_ff1, *w_ff2, *w_rg_a, *w_rg_x, *w_ada, *b_ada, *c_ctx, *c_s, *cak, *cav, *cbk, *cbv; unsigned char* ws; };
__device__ __forceinline__ void tr_dispatch(const P0Args& A, LAS float* scr, int it, int lane) {
    unsigned char* ws = A.ws;
    if (it < 4608) { tr_item<true>(A.w_att_in, DM, NQKV, (bf16_t*)(ws + WS_WQKV), scr, it, lane); return; } it -= 4608;
    if (it < 2048) { tr_item<false>(A.w_att_out, DM, DM, (bf16_t*)(ws + WS_WO), scr, it, lane); return; } it -= 2048;
    if (it < 4096) { tr_item<false>(A.w_rec_in, DM, NREC, (bf16_t*)(ws + WS_WRIN), scr, it, lane); return; } it -= 4096;
    if (it < 2048) { tr_item<false>(A.w_rec_out, DM, DM, (bf16_t*)(ws + WS_WROUT), scr, it, lane); return; } it -= 2048;
    if (it < 16384) { const int l = it >> 13; tr_item<false>(A.w_ff1 + (size_t)l * DM * DFF, DM, DFF, (bf16_t*)(ws + WS_W1) + (size_t)l * DM * DFF, scr, it & 8191, lane); return; } it -= 16384;
    if (it < 16384) { const int l = it >> 13; tr_item<false>(A.w_ff2 + (size_t)l * DM * DFF, DFF, DM, (bf16_t*)(ws + WS_W2) + (size_t)l * DM * DFF, scr, it & 8191, lane); return; } it -= 16384;
    { const int mat = it >> 3, gate = mat >> 5, dn = mat & 31;
      const float* src = (gate ? A.w_rg_x : A.w_rg_a) + (size_t)dn * 16384;
      bf16_t* dst = (bf16_t*)(ws + WS_WG) + (size_t)(((dn >> 4) * 2 + gate) * 16 + (dn & 15)) * 16384;
      tr_item<false>(src, 128, 128, dst, scr, it & 7, lane); }
}
constexpr int N_TR_ITEMS = 4608 + 2048 + 4096 + 2048 + 16384 + 16384 + 512;
constexpr int N_ADA_ITEMS = 1536;
__device__ __forceinline__ void p0_prologue(const P0Args& A, LAS unsigned char* lds, int G, int bid, int tid) {
    const int wave = __builtin_amdgcn_readfirstlane(tid >> 6), lane = tid & 63;
    LAS float* scr = (LAS float*)(lds + wave * 8704);
    const int gw = bid * 8 + wave, NGW = G * 8;
    {
        unsigned char* ws = A.ws; const int gt = bid * 512 + tid, NT = G * 512;
        bf16_t* cKa = (bf16_t*)(ws + WS_CKA); bf16_t* cVta = (bf16_t*)(ws + WS_CVTA); bf16_t* cKb = (bf16_t*)(ws + WS_CKB); bf16_t* cVtb = (bf16_t*)(ws + WS_CVTB); float* rope = (float*)(ws + WS_ROPE);
        for (int i = gt; i < 524288; i += NT) { const int b = i >> 18, t = (i >> 10) & 255, c = i & 1023, hd = c >> 7, d = c & 127, kl = t & 31, slot = (kl & ~12) | ((kl & 4) << 1) | ((kl & 8) >> 1);
            cKa[((((((size_t)(b * 8 + hd) * 8 + (t >> 5)) * 8 + (d >> 4)) * 2 + ((d >> 3) & 1)) * 32 + slot) * 8) + (d & 7)] = (bf16_t)(pk2(A.cak[i], 0.f) & 0xffffu);
            cVta[(((((((size_t)(b * 8 + hd) * 8 + (t >> 5)) * 4 + (d >> 5)) * 2 + (kl >> 4)) * 2 + ((kl >> 3) & 1)) * 32 + (d & 31)) * 8) + (kl & 7)] = (bf16_t)(pk2(A.cav[i], 0.f) & 0xffffu); }
        for (int i = gt; i < 131072; i += NT) { const int b = i >> 16, t = (i >> 8) & 255, c = i & 255, hd = c >> 7, d = c & 127, kl = t & 31, slot = (kl & ~12) | ((kl & 4) << 1) | ((kl & 8) >> 1);
            cKb[((((((size_t)(b * 2 + hd) * 8 + (t >> 5)) * 8 + (d >> 4)) * 2 + ((d >> 3) & 1)) * 32 + slot) * 8) + (d & 7)] = (bf16_t)(pk2(A.cbk[(i & ~127) + sigma_rope(d)], 0.f) & 0xffffu);
            cVtb[(((((((size_t)(b * 2 + hd) * 8 + (t >> 5)) * 4 + (d >> 5)) * 2 + (kl >> 4)) * 2 + ((kl >> 3) & 1)) * 32 + (d & 31)) * 8) + (kl & 7)] = (bf16_t)(pk2(A.cbv[i], 0.f) & 0xffffu); }
        for (int i = gt; i < 2048; i += NT) { const int pos = i >> 5, e = i & 31; const float inv = powf(10000.f, -(float)e / 32.f); const float ang = (float)pos * inv; rope[2 * i] = cosf(ang); rope[2 * i + 1] = sinf(ang); }
    }
    for (int it = gw; it < N_ADA_ITEMS; it += NGW) ada_item(A.w_ada, A.b_ada, A.c_ctx, A.c_s, (float*)(A.ws + WS_MOD), scr, it, lane);
    for (int trrep = 0; trrep < 1 + (((REP_MASK) >> 16) & 1); ++trrep)
    if (NGW == 2048) {
        if (gw >= 1536) for (int i = 0; i < 16; ++i) tr_dispatch(A, scr, (gw - 1536) + 512 * i, lane);
        for (int it = 8192 + gw; it < N_TR_ITEMS; it += NGW) tr_dispatch(A, scr, it, lane);
    } else {
        for (int it = gw; it < N_TR_ITEMS; it += NGW) tr_dispatch(A, scr, it, lane);
    }
}

__device__ __forceinline__ void norm_row(const float* __restrict__ resid, const float* __restrict__ o, const float* __restrict__ gate, const float* __restrict__ gpost,
                                         float* yout, const float* __restrict__ gnext, const float* __restrict__ sc, const float* __restrict__ sh, bf16_t* xn, int lane) {
    f32x4 y[8];
#pragma unroll
    for (int j = 0; j < 8; ++j) y[j] = *(const f32x4*)(resid + 4 * lane + 256 * j);
    if (o) {
        f32x4 ov[8]; float s = 0.f;
#pragma unroll
        for (int j = 0; j < 8; ++j) { ov[j] = *(const f32x4*)(o + 4 * lane + 256 * j); s += (ov[j][0] * ov[j][0] + ov[j][1] * ov[j][1]) + (ov[j][2] * ov[j][2] + ov[j][3] * ov[j][3]); }
        const float rstd = 1.f / sqrtf(wave_sum(s) * (1.f / DM) + 1e-6f);
        asm volatile("" ::: "memory");
#pragma unroll
        for (int j = 0; j < 8; ++j) { const f32x4 g = *(const f32x4*)(gate + 4 * lane + 256 * j), gp = *(const f32x4*)(gpost + 4 * lane + 256 * j); y[j] = y[j] + g * (ov[j] * rstd * gp); }
    }
    if (yout) {
#pragma unroll
        for (int j = 0; j < 8; ++j) *(f32x4*)(yout + 4 * lane + 256 * j) = y[j];
    }
    if (xn) {
        float s = 0.f;
#pragma unroll
        for (int j = 0; j < 8; ++j) s += (y[j][0] * y[j][0] + y[j][1] * y[j][1]) + (y[j][2] * y[j][2] + y[j][3] * y[j][3]);
        const float rstd = 1.f / sqrtf(wave_sum(s) * (1.f / DM) + 1e-6f);
        asm volatile("" ::: "memory");
#pragma unroll
        for (int j = 0; j < 8; ++j) { const f32x4 gn = *(const f32x4*)(gnext + 4 * lane + 256 * j), s1 = *(const f32x4*)(sc + 4 * lane + 256 * j), s0 = *(const f32x4*)(sh + 4 * lane + 256 * j);
            const f32x4 h = y[j] * rstd * gn * (s1 + 1.f) + s0; u32x2 w; w.x = pk2(h[0], h[1]); w.y = pk2(h[2], h[3]); *(u32x2*)(xn + 4 * lane + 256 * j) = w; }
    }
}

struct AttnSt { f32x16 o[4]; float m, l; };
__device__ __forceinline__ int pi32(int i) { return (i & ~12) | ((i & 4) << 1) | ((i & 8) >> 1); }
__device__ __forceinline__ void attn_loadk(bf16x8 (&kf)[8], const bf16_t* __restrict__ kp) {
#pragma unroll
    for (int d0 = 0; d0 < 8; ++d0) kf[d0] = *(const bf16x8*)(kp + d0 * 512);
}
__device__ __forceinline__ void attn_loadv(bf16x8 (&vf)[4][2], const bf16_t* __restrict__ vp) {
#pragma unroll
    for (int db = 0; db < 4; ++db)
#pragma unroll
        for (int s2 = 0; s2 < 2; ++s2) vf[db][s2] = *(const bf16x8*)(vp + (db * 2 + s2) * 512);
}
__device__ __forceinline__ void attn_init(AttnSt& st) {
#pragma unroll
    for (int db = 0; db < 4; ++db)
#pragma unroll
        for (int r = 0; r < 16; ++r) st.o[db][r] = 0.f;
    st.m = -1e30f; st.l = 0.f;
}
__device__ __forceinline__ void attn_finish(AttnSt& st, bf16_t* orow, int hi, float sinkl2) {
    float l = st.l + __shfl_xor(st.l, 32);
    l += __builtin_amdgcn_exp2f(sinkl2 - st.m);
    const float inv = 1.f / l;
#pragma unroll
    for (int db = 0; db < 4; ++db)
#pragma unroll
        for (int rg = 0; rg < 4; ++rg) { u32x2 w; w.x = pk2(st.o[db][4 * rg] * inv, st.o[db][4 * rg + 1] * inv); w.y = pk2(st.o[db][4 * rg + 2] * inv, st.o[db][4 * rg + 3] * inv);
            *(u32x2*)(orow + db * 32 + 8 * rg + 4 * hi) = w; }
}
struct AttnArgs { const bf16_t *QKV, *KF, *VF, *cKa, *cVta, *cKb, *cVtb; bf16_t* AO; const float *sink, *rpb; };
__device__ __forceinline__ void attn_unit(const AttnArgs& A, const LAS float* rpbL, int kind, int u, int lane_) {
    int lane = lane_; asm volatile("" : "+v"(lane));
    const int r32 = lane & 31, hi = lane >> 5, loff = (hi * 32 + r32) * 8;
    int row, qcol, ocol, nctx = 0, ntl, kmode = 0, r0 = 0, rq = 0, jq = 0, k0 = 0, qpos = 0, h = 0, ltile0 = 0;
    const bf16_t *ckp = nullptr, *cvp = nullptr, *lkp, *lvp; float sinkl2 = -1e30f;
    if (kind == 0) {
        const int qb = u & 7, h16 = (u >> 3) & 15, b = u >> 7; const bool isb = h16 >= 8; const int hq = h16 - 8;
        qcol = isb ? 3072 + hq * 128 : h16 * 128; ocol = isb ? 1024 + hq * 128 : h16 * 128;
        const int kvhead = isb ? 8 + (hq >> 2) : h16;
        row = b * 256 + qb * 32 + r32; ntl = 8; ltile0 = b * 8;
        lkp = A.KF + (size_t)kvhead * 192 * 4096 + loff; lvp = A.VF + (size_t)kvhead * 192 * 4096 + loff;
        if (isb) sinkl2 = A.sink[hq] * L2E_;
    } else if (kind == 1) {
        const int qb = u & 31, b = u >> 8; h = (u >> 5) & 7; rq = qb >> 1; const int jq0 = (qb & 1) * 32, tokbase = 4096 + b * 1024;
        row = tokbase + rq * 64 + jq0 + r32; qcol = h * 128; ocol = h * 128; nctx = 8; ntl = 16; kmode = 1; r0 = min(max(rq - 4, 0), 8); jq = jq0 + r32; ltile0 = tokbase >> 5;
        ckp = A.cKa + (size_t)(b * 8 + h) * 8 * 4096 + loff; cvp = A.cVta + (size_t)(b * 8 + h) * 8 * 4096 + loff;
        lkp = A.KF + (size_t)h * 192 * 4096 + loff; lvp = A.VF + (size_t)h * 192 * 4096 + loff;
    } else {
        const int qb = u & 31, hq = (u >> 5) & 7, b = u >> 8, kvh = hq >> 2, tokbase = 4096 + b * 1024;
        row = tokbase + qb * 32 + r32; qcol = 3072 + hq * 128; ocol = 1024 + hq * 128; nctx = 8; kmode = 2; qpos = qb * 32 + r32; ltile0 = tokbase >> 5;
        k0 = max(qb - 4, 0); ntl = min(qb + 4, 31) - k0 + 1;
        ckp = A.cKb + (size_t)(b * 2 + kvh) * 8 * 4096 + loff; cvp = A.cVtb + (size_t)(b * 2 + kvh) * 8 * 4096 + loff;
        lkp = A.KF + (size_t)(8 + kvh) * 192 * 4096 + loff; lvp = A.VF + (size_t)(8 + kvh) * 192 * 4096 + loff;
        sinkl2 = A.sink[hq] * L2E_;
    }
    const int nt = nctx + ntl;
    bf16x8 qf[8];
    { const bf16_t* qp = A.QKV + (size_t)row * NQKV + qcol + 8 * hi;
#pragma unroll
      for (int d0 = 0; d0 < 8; ++d0) qf[d0] = *(const bf16x8*)(qp + 16 * d0); }
    AttnSt st; attn_init(st);
#define LTILE(j) (ltile0 + ((kind == 1) ? ((r0 + ((j) >> 1)) * 2 + ((j) & 1)) : (kind == 2) ? (k0 + (j)) : (j)))
#define KPTR(i) (((i) < nctx) ? ckp + (size_t)(i) * 4096 : lkp + (size_t)LTILE((i) - nctx) * 4096)
#define VPTR(i) (((i) < nctx) ? cvp + (size_t)(i) * 4096 : lvp + (size_t)LTILE((i) - nctx) * 4096)
    bf16x8 kf[8], vf[4][2];
    attn_loadk(kf, KPTR(0)); attn_loadv(vf, VPTR(0));
    constexpr float SC = 0.08838834764831845f * L2E_;
#pragma unroll 1
    for (int i = 0; i < nt; ++i) {
        f32x16 s = {0.f, 0.f, 0.f, 0.f, 0.f, 0.f, 0.f, 0.f, 0.f, 0.f, 0.f, 0.f, 0.f, 0.f, 0.f, 0.f};
#pragma unroll
        for (int d0 = 0; d0 < 8; ++d0) s = __builtin_amdgcn_mfma_f32_32x32x16_bf16(kf[d0], qf[d0], s, 0, 0, 0);
        const int in = (i + 1 < nt) ? i + 1 : i;
        attn_loadk(kf, KPTR(in));
        const int mode = (i < nctx) ? 0 : kmode, j = i - nctx;
        float t[16]; float mx = -1e30f;
        if (mode == 1) {
            const int kr = r0 + (j >> 1), a0 = (j & 1) * 32; const LAS float* rp = rpbL + (h * 15 + (kr - rq + 7)) * 31;
            const int sc0 = min(max(jq - 8, 0), 48);
#pragma unroll
            for (int r = 0; r < 16; ++r) { const int kc = a0 + (r & 7) + 8 * hi + 16 * (r >> 3); const bool valid = (kc >= sc0) && (kc < sc0 + 16); const int dc = min(max(kc - jq + 15, 0), 30);
                const float bias = rp[dc]; const float v = valid ? s[r] * SC + bias * L2E_ : -1e30f; t[r] = v; mx = fmaxf(mx, v); }
        } else if (mode == 2) {
            const int a0 = (k0 + j) * 32;
#pragma unroll
            for (int r = 0; r < 16; ++r) { const int d = qpos - (a0 + (r & 7) + 8 * hi + 16 * (r >> 3)); const float v = (d <= 128 && d >= -128) ? s[r] * SC : -1e30f; t[r] = v; mx = fmaxf(mx, v); }
        } else {
#pragma unroll
            for (int r = 0; r < 16; ++r) { const float v = s[r] * SC; t[r] = v; mx = fmaxf(mx, v); }
        }
        mx = fmaxf(mx, __shfl_xor(mx, 32));
        const float mnew = fmaxf(st.m, mx), alpha = __builtin_amdgcn_exp2f(st.m - mnew); st.m = mnew;
        float ps = 0.f;
#pragma unroll
        for (int r = 0; r < 16; ++r) { t[r] = __builtin_amdgcn_exp2f(t[r] - mnew); ps += t[r]; }
        st.l = st.l * alpha + ps;
#pragma unroll
        for (int db = 0; db < 4; ++db) st.o[db] = st.o[db] * alpha;
        bf16x8 pf[2];
#pragma unroll
        for (int s2 = 0; s2 < 2; ++s2) { u32x4 w; w.x = pk2(t[8 * s2 + 0], t[8 * s2 + 1]); w.y = pk2(t[8 * s2 + 2], t[8 * s2 + 3]); w.z = pk2(t[8 * s2 + 4], t[8 * s2 + 5]); w.w = pk2(t[8 * s2 + 6], t[8 * s2 + 7]); pf[s2] = __builtin_bit_cast(bf16x8, w); }
#pragma unroll
        for (int db = 0; db < 4; ++db)
#pragma unroll
            for (int s2 = 0; s2 < 2; ++s2) st.o[db] = __builtin_amdgcn_mfma_f32_32x32x16_bf16(vf[db][s2], pf[s2], st.o[db], 0, 0, 0);
        attn_loadv(vf, VPTR(in));
    }
#undef LTILE
#undef KPTR
#undef VPTR
    attn_finish(st, A.AO + (size_t)row * DM + ocol, hi, sinkl2);
}
__device__ __forceinline__ void attn_phase(const AttnArgs& A, LAS unsigned char* lds, int G, int bid, int tid) {
    const int wave = __builtin_amdgcn_readfirstlane(tid >> 6), lane = tid & 63, gw = bid * 8 + wave, NGW = G * 8;
    LAS float* rpbL = (LAS float*)lds;
    for (int i = tid; i < 8 * 15 * 31; i += 512) rpbL[i] = A.rpb[i];
    __syncthreads();
    const bool fast = (NGW == 2048);
#pragma unroll 1
    for (int it = 0;; ++it) {
        int kind, uu;
        if (fast) { if (gw < 1024) { if (it) break; kind = (gw < 512) ? 1 : 2; uu = gw & 511; } else { if (it >= 2) break; kind = 0; uu = 2 * (gw - 1024) + it; } }
        else { const int v = gw + it * NGW; if (v >= 3072) break; if (v < 512) { kind = 1; uu = v; } else if (v < 1024) { kind = 2; uu = v - 512; } else { kind = 0; uu = v - 1024; } }
        attn_unit(A, rpbL, kind, uu, lane);
    }
}

struct ScanArgs { const bf16_t* XRG; float* HF; bf16_t* YR; const bf16_t* WG; const float *conv_w, *conv_b, *b_a, *b_x, *lam, *st_f, *st_b; float* out; };
__device__ __forceinline__ float fsig(float x) { return __builtin_amdgcn_rcpf(1.f + __builtin_amdgcn_exp2f(-L2E * x)); }
__device__ __forceinline__ float gelu_tanh(float x) { const float u = 0.7978845608028654f * (x + 0.044715f * x * x * x); const float e = __builtin_amdgcn_exp2f(2.f * L2E * u); return 0.5f * x * (2.f - 2.f * __builtin_amdgcn_rcpf(e + 1.f)); }
__device__ __forceinline__ void rg_unit(const ScanArgs& A, LAS unsigned char* lds, int u, int tid_) {
    const bool prompt = u >= 128;
    int s, n, sub; { const int v = prompt ? u - 128 : u; s = (prompt ? 0 : 16) + (v >> 6); n = (v >> 2) & 15; sub = v & 3; }
    const int T = prompt ? 256 : 1024, row0 = prompt ? s * 256 : 4096 + (s - 16) * 1024, c0 = n * 128, co = c0 + 32 * sub, nsteps = prompt ? 1 : 8;
    LAS unsigned char* Abf = lds;
    LAS float* XCB = (LAS float*)(lds + 69632);
    LAS float* AA = (LAS float*)(lds + 102400);
    LAS float* SEGA = (LAS float*)(lds + 135168);
    LAS float* SEGB = (LAS float*)(lds + 137216);
    LAS float* CAR = (LAS float*)(lds + 139264);
#pragma unroll 1
    for (int step = 0; step < nsteps; ++step) {
        int tid = tid_; asm volatile("" : "+v"(tid));
        const int wave = __builtin_amdgcn_readfirstlane(tid >> 6), lane = tid & 63, r32 = lane & 31, hi = lane >> 5;
        const int mode = prompt ? 0 : (step < 4 ? 1 : 2), cc = prompt ? 0 : (step < 4 ? step : 7 - step), t0 = cc * 256, par = step & 1;
        if (!prompt && (step == 0 || step == 4) && tid < 32) { const float vf = A.st_f[(s - 16) * 2048 + co + tid], vb = A.st_b[(s - 16) * 2048 + co + tid]; CAR[tid] = step ? vb : vf; }
        {
            const int cq = tid & 31, tg = tid >> 5;
            f32x4 cw[4];
#pragma unroll
            for (int k = 0; k < 4; ++k) cw[k] = *(const f32x4*)(A.conv_w + k * 2048 + c0 + 4 * cq);
            const f32x4 cbv = *(const f32x4*)(A.conv_b + c0 + 4 * cq);
            const bf16_t* xb = A.XRG + (size_t)row0 * NREC + c0 + 4 * cq;
            u32x2 xraw[19];
#pragma unroll
            for (int i = 0; i < 19; ++i) { const int t = t0 + 16 * tg - 2 + i; xraw[i] = (t >= 0 && t < T) ? *(const u32x2*)(xb + (size_t)t * NREC) : (u32x2){0u, 0u}; }
            const bool wxc = (cq >> 3) == sub;
#pragma unroll
            for (int tt = 0; tt < 16; ++tt) { f32x4 v = cbv;
#pragma unroll
                for (int k = 0; k < 4; ++k) { const u32x2 x = xraw[tt + k]; const f32x4 xf = {bf2f((unsigned short)(x.x & 0xffffu)), bf2f((unsigned short)(x.x >> 16)), bf2f((unsigned short)(x.y & 0xffffu)), bf2f((unsigned short)(x.y >> 16))}; v += cw[k] * xf; }
                const int t = 16 * tg + tt;
                u32x2 w; w.x = pk2(v[0], v[1]); w.y = pk2(v[2], v[3]); *(LAS u32x2*)(Abf + t * 272 + 8 * cq) = w;
                if (wxc) *(LAS f32x4*)(XCB + t * 32 + 4 * (cq & 7)) = v; }
        }
        const int c4 = tid & 7, tr = tid >> 3;
        u32x2 g4[4]; f32x4 hf4[4];
#pragma unroll
        for (int i = 0; i < 4; ++i) { g4[i] = (u32x2){0u, 0u}; hf4[i] = (f32x4){0.f, 0.f, 0.f, 0.f}; }
        if (mode != 1) {
#pragma unroll
            for (int i = 0; i < 4; ++i) { const size_t r = (size_t)(row0 + t0 + tr + 64 * i); g4[i] = *(const u32x2*)(A.XRG + r * NREC + 2048 + co + 4 * c4); if (mode == 2) hf4[i] = *(const f32x4*)(A.HF + r * DM + co + 4 * c4); }
        }
        __syncthreads();
        float av[2][16], bv[2][16];
#pragma unroll
        for (int d = 0; d < 2; ++d) {
            if ((d == 0 && mode == 2) || (d == 1 && mode == 1)) continue;
            const bf16_t* wgp = A.WG + ((size_t)((d * 2 + 0) * 16 + n) * 128 + 32 * sub + r32) * 128 + 8 * hi;
            bf16x8 wa[8], wx[8];
#pragma unroll
            for (int ks = 0; ks < 8; ++ks) { wa[ks] = *(const bf16x8*)(wgp + 16 * ks); wx[ks] = *(const bf16x8*)(wgp + (size_t)16 * 16384 + 16 * ks); }
            const int jc = d * 2048 + co + r32;
            const float ba = A.b_a[jc], bx = A.b_x[jc], sp = log1pf(__expf(-A.lam[jc]));
            f32x16 ga = {0.f, 0.f, 0.f, 0.f, 0.f, 0.f, 0.f, 0.f, 0.f, 0.f, 0.f, 0.f, 0.f, 0.f, 0.f, 0.f}, gx = ga;
#pragma unroll
            for (int ks = 0; ks < 8; ++ks) { const bf16x8 af = *(const LAS bf16x8*)(Abf + (32 * wave + r32) * 272 + (16 * ks + 8 * hi) * 2);
                ga = __builtin_amdgcn_mfma_f32_32x32x16_bf16(af, wa[ks], ga, 0, 0, 0); gx = __builtin_amdgcn_mfma_f32_32x32x16_bf16(af, wx[ks], gx, 0, 0, 0); }
#pragma unroll
            for (int r = 0; r < 16; ++r) { const int t = 32 * wave + (r & 3) + 8 * (r >> 2) + 4 * hi;
                const float rr = fsig(ga[r] + ba), ii = fsig(gx[r] + bx);
                const float z = -16.f * rr * sp, a = __builtin_amdgcn_exp2f(0.5f * L2E * z);
                const float poly = -z * (1.f + 0.5f * z * (1.f + (1.f / 3.f) * z * (1.f + 0.25f * z * (1.f + 0.2f * z))));
                const float m2 = (z > -0.25f) ? poly : 1.f - a * a;
                av[d][r] = a; bv[d][r] = __builtin_amdgcn_sqrtf(m2) * ii * XCB[t * 32 + r32]; }
        }
        __syncthreads();
        f32x4 hreg[4];
#pragma unroll
        for (int i = 0; i < 4; ++i) hreg[i] = (f32x4){0.f, 0.f, 0.f, 0.f};
#pragma unroll
        for (int d = 0; d < 2; ++d) {
            if ((d == 0 && mode == 2) || (d == 1 && mode == 1)) continue;
#pragma unroll
            for (int r = 0; r < 16; ++r) { const int t = 32 * wave + (r & 3) + 8 * (r >> 2) + 4 * hi; AA[t * 32 + r32] = av[d][r]; XCB[t * 32 + r32] = bv[d][r]; }
            __syncthreads();
            {
                const int sc_c = tid & 31, sg = tid >> 5;
                float a_[16], b_[16]; float Aacc = 1.f, Bacc = 0.f;
#pragma unroll
                for (int k = 0; k < 16; ++k) { const int uu = 16 * sg + k, t = d ? 255 - uu : uu; a_[k] = AA[t * 32 + sc_c]; b_[k] = XCB[t * 32 + sc_c]; Bacc = a_[k] * Bacc + b_[k]; Aacc *= a_[k]; }
                SEGA[sg * 32 + sc_c] = Aacc; SEGB[sg * 32 + sc_c] = Bacc;
                __syncthreads();
                float h = (mode == 0) ? 0.f : CAR[par * 32 + sc_c];
                for (int s2 = 0; s2 < sg; ++s2) h = SEGA[s2 * 32 + sc_c] * h + SEGB[s2 * 32 + sc_c];
#pragma unroll
                for (int k = 0; k < 16; ++k) { const int uu = 16 * sg + k, t = d ? 255 - uu : uu; h = a_[k] * h + b_[k]; XCB[t * 32 + sc_c] = h; }
                if (sg == 15) { if (mode != 0) CAR[(par ^ 1) * 32 + sc_c] = h; else A.out[(d ? OUT_RB : OUT_RF) + s * 2048 + co + sc_c] = h; }
            }
            __syncthreads();
            if (mode == 0 && d == 0) {
#pragma unroll
                for (int i = 0; i < 4; ++i) hreg[i] = *(const LAS f32x4*)(XCB + (tr + 64 * i) * 32 + 4 * c4);
                __syncthreads();
            } else {
#pragma unroll
                for (int i = 0; i < 4; ++i) { const size_t r = (size_t)(row0 + t0 + tr + 64 * i); const f32x4 hv = *(const LAS f32x4*)(XCB + (tr + 64 * i) * 32 + 4 * c4);
                    if (mode == 1) *(f32x4*)(A.HF + r * DM + co + 4 * c4) = hv;
                    else { const f32x4 sum = hv + hreg[i] + hf4[i];
                        const float g0 = gelu_tanh(bf2f((unsigned short)(g4[i].x & 0xffffu))), g1 = gelu_tanh(bf2f((unsigned short)(g4[i].x >> 16))), g2 = gelu_tanh(bf2f((unsigned short)(g4[i].y & 0xffffu))), g3 = gelu_tanh(bf2f((unsigned short)(g4[i].y >> 16)));
                        u32x2 w; w.x = pk2(sum[0] * g0, sum[1] * g1); w.y = pk2(sum[2] * g2, sum[3] * g3); *(u32x2*)(A.YR + r * DM + co + 4 * c4) = w; } }
            }
        }
        __syncthreads();
    }
}
__device__ __forceinline__ void scan_phase(const ScanArgs& A, LAS unsigned char* lds, int G, int bid, int tid) {
#pragma unroll 1
    for (int i = 0;; ++i) {
        int u;
        if (G == 256) {
            if (bid < 128) { if (i == 0) u = bid; else if (i < 3) u = 128 + 2 * bid + (i - 1); else break; }
            else { if (i < 6) u = 128 + 256 + 6 * (bid - 128) + i; else break; }
        } else { u = bid + i * G; if (u >= 1152) break; }
        rg_unit(A, lds, u, tid);
    }
}

#define XB_TMO      128
#define XB_XCNT(j)  (256  + 64 * (j))
#define XB_XSUB(j)  (1280 + 64 * (j))
#define XB_XGEN(j)  (2304 + 64 * (j))
#define XB_TOP      3328
#define XB_TOPGEN   3392
#define XCD_BAR_WORDS 3456
#define XB_SPIN_CAP (1u << 18)

__device__ __forceinline__ unsigned xb_ld(unsigned* p)              { return __hip_atomic_load(p, __ATOMIC_RELAXED, __HIP_MEMORY_SCOPE_AGENT); }
__device__ __forceinline__ unsigned xb_add(unsigned* p, unsigned v) { return __hip_atomic_fetch_add(p, v, __ATOMIC_RELAXED, __HIP_MEMORY_SCOPE_AGENT); }
__device__ __forceinline__ unsigned xb_xcc_id() { return (unsigned)__builtin_amdgcn_s_getreg((3 << 11) | 20) & 0xFu; }
#define XB_SPIN(cond, bar) do { unsigned _sp = 0; while (cond) { __builtin_amdgcn_s_sleep(1); \
    if ((++_sp & 255u) == 0u) { if (xb_ld(&(bar)[XB_TMO])) break; if (_sp > XB_SPIN_CAP) { atomicAdd(&(bar)[XB_TMO], 1u); break; } } } } while (0)

struct XcdBarrier {
    unsigned* bar; unsigned x;
    volatile LAS unsigned* st;
};

__device__ __forceinline__ XcdBarrier xcd_barrier_post(unsigned* bar, volatile LAS unsigned* st) {
    XcdBarrier b; b.bar = bar; b.x = xb_xcc_id(); b.st = st;
    if (threadIdx.x == 0) (void)xb_add(&bar[XB_XCNT(b.x)], 1u);
    return b;
}
__device__ __forceinline__ void xcd_barrier_complete(unsigned* bar, unsigned x, unsigned& nloc, unsigned& nx) {
    const unsigned G = gridDim.x * gridDim.y * gridDim.z;
    unsigned sum, cnt, mine, sp = 0u;
    for (;;) {
        sum = 0u; cnt = 0u; mine = 0u;
#pragma unroll
        for (unsigned j = 0; j < 16; ++j) { const unsigned c = xb_ld(&bar[XB_XCNT(j)]); sum += c; cnt += (c > 0u) ? 1u : 0u; mine = (j == x) ? c : mine; }
        if (sum == G) break;
        __builtin_amdgcn_s_sleep(1);
        if ((++sp & 255u) == 0u) { if (xb_ld(&bar[XB_TMO])) break; if (sp > XB_SPIN_CAP) { atomicAdd(&bar[XB_TMO], 1u); break; } }
    }
    nloc = mine > 0u ? mine : 1u; nx = cnt > 0u ? cnt : 1u;
}

__device__ __forceinline__ void xcd_barrier(const XcdBarrier& b) {
    asm volatile("s_waitcnt vmcnt(0)" ::: "memory");
    __syncthreads();
    if (threadIdx.x == 0) {
        unsigned* bar = b.bar;
        __builtin_amdgcn_s_waitcnt(0);
        unsigned nloc = b.st[0], nx = b.st[1];
        if (nloc == 0u) { xcd_barrier_complete(bar, b.x, nloc, nx); b.st[0] = nloc; b.st[1] = nx; }
        const unsigned old = xb_add(&bar[XB_XSUB(b.x)], 1u);
        const unsigned gen = old / nloc;
        if (old + 1u == (gen + 1u) * nloc) {
            __builtin_amdgcn_fence(__ATOMIC_RELEASE, "agent");
            asm volatile("s_waitcnt vmcnt(0)" ::: "memory");
            const unsigned og = xb_add(&bar[XB_TOP], 1u);
            const unsigned tg = og / nx;
            if (og + 1u == (tg + 1u) * nx) xb_add(&bar[XB_TOPGEN], 1u);
            else XB_SPIN(xb_ld(&bar[XB_TOPGEN]) == tg, bar);
            __builtin_amdgcn_fence(__ATOMIC_ACQUIRE, "agent");
            xb_add(&bar[XB_XGEN(b.x)], 1u);
            asm volatile("s_waitcnt vmcnt(0)" ::: "memory");
        } else {
            XB_SPIN(xb_ld(&bar[XB_XGEN(b.x)]) == gen, bar);
            __builtin_amdgcn_fence(__ATOMIC_ACQUIRE, "agent");
            asm volatile("s_waitcnt vmcnt(0)" ::: "memory");
        }
    }
    __syncthreads();
}

struct Params { const float* in[31]; float* out; unsigned char* ws; int ph_lo, ph_hi; };
__global__ void __launch_bounds__(512, 2) mega_fwd(Params P) {
    extern __shared__ __attribute__((aligned(16))) unsigned char lds_raw[];
    LAS unsigned char* lds = (LAS unsigned char*)lds_raw;
    const int tid = threadIdx.x, G = gridDim.x, bid = blockIdx.x;
    const int wave = __builtin_amdgcn_readfirstlane(tid >> 6), lane = tid & 63;
    unsigned char* ws = P.ws;
    const int lo = P.ph_lo, hi = P.ph_hi;
    bf16_t* XN = (bf16_t*)(ws + WS_XN); bf16_t* QKV = (bf16_t*)(ws + WS_QKV); bf16_t* VT = (bf16_t*)(ws + WS_VT); bf16_t* KFb = (bf16_t*)(ws + WS_KF); bf16_t* AO = (bf16_t*)(ws + WS_AO);
    float* O32 = (float*)(ws + WS_O32); float* Y = (float*)(ws + WS_Y); bf16_t* H = (bf16_t*)(ws + WS_H); bf16_t* XRG = (bf16_t*)(ws + WS_XRG); float* HF = (float*)(ws + WS_HF);
    const float* mod = (const float*)(ws + WS_MOD);
    const float *g_pre_mix = P.in[12], *g_post_mix = P.in[13], *g_pre_ffn = P.in[14], *g_post_ffn = P.in[15];
    volatile LAS unsigned* bst = (volatile LAS unsigned*)(lds + LDS_BYTES - 64);
    if (tid < 2) bst[tid] = 0u;
    __syncthreads();
    if (hi - lo > 1) (void)xcd_barrier_post((unsigned*)(ws + WS_BAR), bst);
    if (lo == -12345) cg::this_grid().sync();
#ifndef PH_MASK
#define PH_MASK 0xFFFF
#endif
#define IN(k) ((((PH_MASK) >> (k)) & 1) && lo <= (k) && (k) < hi)
#define SEAM(k) do { if (IN(k) && IN((k) + 1)) { XcdBarrier bar_; bar_.bar = (unsigned*)(P.ws + WS_BAR); bar_.x = xb_xcc_id(); bar_.st = (volatile LAS unsigned*)(lds + LDS_BYTES - 64); xcd_barrier(bar_); } } while (0)
#define MODP(l, ci, ch) (mod + ((size_t)((l) * 3 + (ci)) * 6 + (ch)) * 2048)
    if (IN(0)) for (int rep_ = 0; rep_ < 1 + (((REP_MASK) >> 0) & 1); ++rep_) {
        P0Args A{P.in[16], P.in[17], P.in[20], P.in[28], P.in[29], P.in[30], P.in[23], P.in[25], P.in[10], P.in[11], P.in[9], P.in[2], P.in[3], P.in[4], P.in[5], P.in[6], ws};
        p0_prologue(A, lds, G, bid, tid);
    }
    SEAM(0);
    if (IN(1)) for (int rep_ = 0; rep_ < 1 + (((REP_MASK) >> 1) & 1); ++rep_) {
_Pragma("unroll 1")
        for (int m = bid * 8 + wave; m < MT; m += G * 8) { const int ci = (m < 4096) ? 0 : 1 + ((m - 4096) >> 10);
            const float* x = (m < 4096) ? P.in[0] + (size_t)m * DM : P.in[1] + (size_t)(m - 4096) * DM;
            norm_row(x, nullptr, nullptr, nullptr, nullptr, g_pre_mix, MODP(0, ci, 1), MODP(0, ci, 0), XN + (size_t)m * DM, lane); }
    }
    SEAM(1);
    if (IN(2)) { constexpr int REPK = 1 + (((REP_MASK) >> 2) & 1);
        pg8::Gemm g{XN, (const bf16_t*)(ws + WS_WQKV), MT, NQKV, DM}; pg8::StaticOrder S; S.init(MT, NQKV, G, bid); S.rep = REPK;
        pg8::EpiQKV E{QKV, KFb, VT, P.out, (const float*)(ws + WS_ROPE)};
        pg8::gemm_phase<pg8::EpiQKV, pg8::StaticOrder, true, true>(lds, g, S, E);
    }
    SEAM(2);
    if (IN(3)) for (int rep_ = 0; rep_ < 1 + (((REP_MASK) >> 3) & 1); ++rep_) {
        AttnArgs A{QKV, KFb, VT, (const bf16_t*)(ws + WS_CKA), (const bf16_t*)(ws + WS_CVTA), (const bf16_t*)(ws + WS_CKB), (const bf16_t*)(ws + WS_CVTB), AO, P.in[18], P.in[19]};
        attn_phase(A, lds, G, bid, tid);
    }
    SEAM(3);
    if (IN(4)) { constexpr int REPK = 1 + (((REP_MASK) >> 4) & 1);
        pg8::Gemm g{AO, (const bf16_t*)(ws + WS_WO), MT, DM, DM}; pg8::StaticOrder S; S.init(MT, DM, G, bid, 192); S.rep = REPK;
        pg8::EpiF32<3> E{O32, DM};
        pg8::gemm_phase<pg8::EpiF32<3>, pg8::StaticOrder, true, true, 3>(lds, g, S, E);
    }
    SEAM(4);
    if (IN(5)) for (int rep_ = 0; rep_ < 1 + (((REP_MASK) >> 5) & 1); ++rep_) {
_Pragma("unroll 1")
        for (int m = bid * 8 + wave; m < MT; m += G * 8) { const int ci = (m < 4096) ? 0 : 1 + ((m - 4096) >> 10);
            const float* x = (m < 4096) ? P.in[0] + (size_t)m * DM : P.in[1] + (size_t)(m - 4096) * DM;
            norm_row(x, O32 + (size_t)m * DM, MODP(0, ci, 2), g_post_mix, Y + (size_t)m * DM, g_pre_ffn, MODP(0, ci, 4), MODP(0, ci, 3), XN + (size_t)m * DM, lane); }
    }
    SEAM(5);
    if (IN(6)) { constexpr int REPK = 1 + (((REP_MASK) >> 6) & 1);
        pg8::Gemm g{XN, (const bf16_t*)(ws + WS_W1), MT, DFF, DM}; pg8::StaticOrder S; S.init(MT, DFF, G, bid); S.rep = REPK;
        pg8::EpiBf16<2, 4> E{H, DFF};
        pg8::gemm_phase<pg8::EpiBf16<2, 4>, pg8::StaticOrder, true, true, 4>(lds, g, S, E);
    }
    SEAM(6);
    if (IN(7)) { constexpr int REPK = 1 + (((REP_MASK) >> 7) & 1);
        pg8::Gemm g{H, (const bf16_t*)(ws + WS_W2), MT, DM, DFF}; pg8::StaticOrder S; S.init(MT, DM, G, bid, 192); S.rep = REPK;
        pg8::EpiF32<3> E{O32, DM};
        pg8::gemm_phase<pg8::EpiF32<3>, pg8::StaticOrder, true, true, 3>(lds, g, S, E);
    }
    SEAM(7);
    if (IN(8)) for (int rep_ = 0; rep_ < 1 + (((REP_MASK) >> 8) & 1); ++rep_) {
_Pragma("unroll 1")
        for (int m = bid * 8 + wave; m < MT; m += G * 8) { const int ci = (m < 4096) ? 0 : 1 + ((m - 4096) >> 10);
            norm_row(Y + (size_t)m * DM, O32 + (size_t)m * DM, MODP(0, ci, 5), g_post_ffn, Y + (size_t)m * DM, g_pre_mix + DM, MODP(1, ci, 1), MODP(1, ci, 0), XN + (size_t)m * DM, lane); }
    }
    SEAM(8);
    if (IN(9)) { constexpr int REPK = 1 + (((REP_MASK) >> 9) & 1);
        pg8::Gemm g{XN, (const bf16_t*)(ws + WS_WRIN), MT, NREC, DM}; pg8::StaticOrder S; S.init(MT, NREC, G, bid, 192); S.rep = REPK;
        pg8::EpiBf16<0, 3> E{XRG, NREC};
        pg8::gemm_phase<pg8::EpiBf16<0, 3>, pg8::StaticOrder, true, true, 3>(lds, g, S, E);
    }
    SEAM(9);
    if (IN(10)) for (int rep_ = 0; rep_ < 1 + (((REP_MASK) >> 10) & 1); ++rep_) {
        ScanArgs A{XRG, HF, AO, (const bf16_t*)(ws + WS_WG), P.in[21], P.in[22], P.in[24], P.in[26], P.in[27], P.in[7], P.in[8], P.out};
        scan_phase(A, lds, G, bid, tid);
    }
    SEAM(10);
    if (IN(11)) { constexpr int REPK = 1 + (((REP_MASK) >> 11) & 1);
        pg8::Gemm g{AO, (const bf16_t*)(ws + WS_WROUT), MT, DM, DM}; pg8::StaticOrder S; S.init(MT, DM, G, bid, 192); S.rep = REPK;
        pg8::EpiF32<3> E{O32, DM};
        pg8::gemm_phase<pg8::EpiF32<3>, pg8::StaticOrder, true, true, 3>(lds, g, S, E);
    }
    SEAM(11);
    if (IN(12)) for (int rep_ = 0; rep_ < 1 + (((REP_MASK) >> 12) & 1); ++rep_) {
_Pragma("unroll 1")
        for (int m = bid * 8 + wave; m < MT; m += G * 8) { const int ci = (m < 4096) ? 0 : 1 + ((m - 4096) >> 10);
            norm_row(Y + (size_t)m * DM, O32 + (size_t)m * DM, MODP(1, ci, 2), g_post_mix + DM, Y + (size_t)m * DM, g_pre_ffn + DM, MODP(1, ci, 4), MODP(1, ci, 3), XN + (size_t)m * DM, lane); }
    }
    SEAM(12);
    if (IN(13)) { constexpr int REPK = 1 + (((REP_MASK) >> 13) & 1);
        pg8::Gemm g{XN, (const bf16_t*)(ws + WS_W1) + (size_t)DM * DFF, MT, DFF, DM}; pg8::StaticOrder S; S.init(MT, DFF, G, bid); S.rep = REPK;
        pg8::EpiBf16<2, 4> E{H, DFF};
        pg8::gemm_phase<pg8::EpiBf16<2, 4>, pg8::StaticOrder, true, true, 4>(lds, g, S, E);
    }
    SEAM(13);
    if (IN(14)) { constexpr int REPK = 1 + (((REP_MASK) >> 14) & 1);
        pg8::Gemm g{H, (const bf16_t*)(ws + WS_W2) + (size_t)DM * DFF, MT, DM, DFF}; pg8::StaticOrder S; S.init(MT, DM, G, bid, 192); S.rep = REPK;
        pg8::EpiF32<3> E{O32, DM};
        pg8::gemm_phase<pg8::EpiF32<3>, pg8::StaticOrder, true, true, 3>(lds, g, S, E);
    }
    SEAM(14);
    if (IN(15)) for (int rep_ = 0; rep_ < 1 + (((REP_MASK) >> 15) & 1); ++rep_) {
_Pragma("unroll 1")
        for (int m = bid * 8 + wave; m < MT; m += G * 8) { const int ci = (m < 4096) ? 0 : 1 + ((m - 4096) >> 10);
            norm_row(Y + (size_t)m * DM, O32 + (size_t)m * DM, MODP(1, ci, 5), g_post_ffn + DM, P.out + (size_t)m * DM, nullptr, nullptr, nullptr, nullptr, lane); }
    }
#undef IN
#undef SEAM
#undef MODP
}

#ifndef MK_MULTI
#define MK_MULTI 0
#endif
extern "C" void kernel_launch(void* const* d_in, const int* in_sizes, int n_in, void* d_out, int out_size, void* d_ws, size_t ws_size, hipStream_t stream) {
    static int grid = 0;
    if (grid == 0) {
        if (n_in != 31 || ws_size < WS_END) { fprintf(stderr, "kernel_launch: unexpected n_in %d / ws %zu\n", n_in, ws_size); grid = -1; return; }
        int dev = 0, cus = 0, per_cu = 0;
        (void)hipGetDevice(&dev); (void)hipDeviceGetAttribute(&cus, hipDeviceAttributeMultiprocessorCount, dev);
        (void)hipFuncSetAttribute((const void*)mega_fwd, hipFuncAttributeMaxDynamicSharedMemorySize, LDS_BYTES);
        (void)hipOccupancyMaxActiveBlocksPerMultiprocessor(&per_cu, (const void*)mega_fwd, 512, LDS_BYTES);
        if (per_cu < 1) per_cu = 1;
        grid = cus * 1;
        if (grid <= 0) grid = 256;
        (void)hipGetLastError();
    }
    if (grid < 0) return;
    (void)hipMemsetAsync((char*)d_ws + WS_MOD, 0, CTL_ZERO_BYTES, stream);
    Params p{};
    for (int i = 0; i < 31; ++i) p.in[i] = (const float*)d_in[i];
    p.out = (float*)d_out; p.ws = (unsigned char*)d_ws;
#if MK_MULTI
    for (int ph = 0; ph < NPHASE; ++ph) { p.ph_lo = ph; p.ph_hi = ph + 1; hipLaunchKernelGGL(mega_fwd, dim3(grid), dim3(512), LDS_BYTES, stream, p); }
#else
    p.ph_lo = 0; p.ph_hi = NPHASE;
    void* args[] = {&p};
    hipError_t e = hipLaunchCooperativeKernel((const void*)mega_fwd, dim3(grid), dim3(512), args, LDS_BYTES, stream);
    if (e != hipSuccess) fprintf(stderr, "cooperative launch failed: %s (grid %d)\n", hipGetErrorString(e), grid);
#endif
}
```
